# Optimizing an MI355X kernel written in HIP

```python
import math
import jax, jax.numpy as jnp
from jax import lax
import numpy as np

D_MODEL = 1024
BATCH = 4
SEQ = 4096
DEPTH = 4

CTX_LEN = 256
GRID_W = 64
NORM_EPS = 1e-6

ML_HEADS = 4
ML_DK = 256
ML_DV = 256
ML_W = ML_HEADS * ML_DV
ML_CHUNK = 128

DA_HEADS = 8
DA_DH = 64
DA_DV = 2 * DA_DH
DA_QK_W = DA_HEADS * 2 * DA_DH
DA_V_W = DA_HEADS * DA_DV
Q_BLOCK = 128
ROPE_BASE = 10000.0

FN_GROUPS = 4
FN_GC = 256
FN_W = FN_GROUPS * FN_GC

N_BRANCH = 3
D_FF = -(-8 * D_MODEL // (3 * 256)) * 256

IN_SPLITS = (ML_DK * ML_HEADS, ML_DK * ML_HEADS, ML_W, ML_W, 4 * ML_HEADS,
             DA_QK_W, DA_QK_W, DA_V_W, FN_W, N_BRANCH * D_MODEL)
D_IN = sum(IN_SPLITS)

kernel_name = 'hybrid_mlstm_diffattn_fnet_dit'


def _rmsnorm(x, g):
    xf = x.astype(jnp.float32)
    y = xf * lax.rsqrt(jnp.mean(xf * xf, axis=-1, keepdims=True) + NORM_EPS)
    return (y * g.astype(jnp.float32)).astype(x.dtype)


def _modulate(h, shift, scale):
    return h * (1 + scale) + shift


def _split_cols(u):
    idx, acc = [], 0
    for s in IN_SPLITS[:-1]:
        acc += s
        idx.append(acc)
    return jnp.split(u, idx, axis=-1)


def _axial_rope(rows):
    n_freq = DA_DH // 4
    inv = ROPE_BASE ** (-jnp.arange(n_freq, dtype=jnp.float32) / n_freq)
    r = jnp.repeat(jnp.arange(rows, dtype=jnp.float32), GRID_W)
    col = jnp.tile(jnp.arange(GRID_W, dtype=jnp.float32), rows)
    ang = jnp.concatenate([r[:, None] * inv, col[:, None] * inv], axis=-1)
    return jnp.cos(ang), jnp.sin(ang)


def _rope(x, cos, sin):
    shp = (cos.shape[0],) + (1,) * (x.ndim - 3) + (cos.shape[1],)
    c = cos.reshape(shp).astype(x.dtype)
    s = sin.reshape(shp).astype(x.dtype)
    x1, x2 = jnp.split(x, 2, axis=-1)
    return jnp.concatenate([x1 * c - x2 * s, x1 * s + x2 * c], axis=-1)


def _mlstm_scan(q, k, v, i_pre, f_pre, state):
    B, T, H, DK = q.shape
    DV = v.shape[-1]
    L = ML_CHUNK
    NC = T // L

    def chunks(a):
        a = a.astype(jnp.float32).reshape((B, NC, L, H) + a.shape[3:])
        return jnp.moveaxis(jnp.moveaxis(a, 1, 0), 3, 2)

    tri = jnp.tril(jnp.ones((L, L), dtype=bool))

    def step(carry, xs):
        C, n, m = carry
        qc, kc, vc, ic, fc = xs
        b = jnp.cumsum(jax.nn.log_sigmoid(fc), axis=-1)
        dmat = jnp.where(tri, b[..., :, None] - b[..., None, :] + ic[..., None, :], -jnp.inf)
        inter = b + m[..., None]
        m_t = jnp.maximum(inter, jnp.max(dmat, axis=-1))
        a = jnp.exp(dmat - m_t[..., None]) * jnp.einsum('bhtd,bhsd->bhts', qc, kc)
        sc = jnp.exp(inter - m_t)
        num = sc[..., None] * jnp.einsum('bhtd,bhde->bhte', qc, C) + jnp.einsum('bhts,bhse->bhte', a, vc)
        den = sc * jnp.einsum('bhtd,bhd->bht', qc, n) + jnp.sum(a, axis=-1)
        h = num / jnp.maximum(jnp.abs(den), jnp.exp(-m_t))[..., None]
        b_end = b[..., -1]
        g_s = b_end[..., None] - b + ic
        m_new = jnp.maximum(b_end + m, jnp.max(g_s, axis=-1))
        decay = jnp.exp(b_end + m - m_new)
        kw = kc * jnp.exp(g_s - m_new[..., None])[..., None]
        C_new = decay[..., None, None] * C + jnp.einsum('bhsd,bhse->bhde', kw, vc)
        n_new = decay[..., None] * n + jnp.sum(kw, axis=2)
        return (C_new, n_new, m_new), h

    final, hs = lax.scan(step, state, (chunks(q), chunks(k), chunks(v), chunks(i_pre), chunks(f_pre)))
    h = jnp.transpose(hs, (1, 0, 3, 2, 4)).reshape(B, T, H, DV)
    return h, final


def _mlstm_branch(ul, uc, gate_b, head_g):
    def prep(u):
        B, T, _ = u[0].shape
        q = u[0].reshape(B, T, ML_HEADS, ML_DK)
        k = u[1].reshape(B, T, ML_HEADS, ML_DK) * (ML_DK ** -0.5)
        v = u[2].reshape(B, T, ML_HEADS, ML_DV)
        i_f, f_f, i_b, f_b = jnp.split(u[4] + gate_b, 4, axis=-1)
        return q, k, v, i_f, f_f, i_b, f_b

    flip = lambda a: jnp.flip(a, axis=1)
    ql, kl, vl, ifl, ffl, ibl, fbl = prep(ul)
    qc, kc, vc, ifc, ffc, ibc, fbc = prep(uc)
    B = ql.shape[0]
    zero = (jnp.zeros((B, ML_HEADS, ML_DK, ML_DV), jnp.float32),
            jnp.zeros((B, ML_HEADS, ML_DK), jnp.float32),
            jnp.zeros((B, ML_HEADS), jnp.float32))
    hcf, st_f = _mlstm_scan(qc, kc, vc, ifc, ffc, zero)
    hlf, _ = _mlstm_scan(ql, kl, vl, ifl, ffl, st_f)
    hcb, st_b = _mlstm_scan(flip(qc), flip(kc), flip(vc), flip(ibc), flip(fbc), zero)
    hlb, _ = _mlstm_scan(flip(ql), flip(kl), flip(vl), flip(ibl), flip(fbl), st_b)

    def out(hf, hb, u):
        B, T = hf.shape[:2]
        h = _rmsnorm(hf + hb, head_g.reshape(ML_HEADS, ML_DV)).reshape(B, T, ML_W)
        return h.astype(u[3].dtype) * jax.nn.sigmoid(u[3])

    return out(hlf, flip(hlb), ul), out(hcf, flip(hcb), uc)


def _diff_attn_core(q, k, v, lam):
    s = jnp.einsum('bqhmd,bkhmd->bhmqk', q, k).astype(jnp.float32) * (DA_DH ** -0.5)
    p = jax.nn.softmax(s, axis=-1)
    a = p[:, :, 0] - lam * p[:, :, 1]
    return jnp.einsum('bhqk,bkhe->bqhe', a.astype(v.dtype), v)


def _diff_attn_branch(ul, uc, lam_qk, head_g, cos, sin, lam_init, need_ctx):
    def qkv(u):
        B, T, _ = u[5].shape
        return (u[5].reshape(B, T, DA_HEADS, 2, DA_DH),
                u[6].reshape(B, T, DA_HEADS, 2, DA_DH),
                u[7].reshape(B, T, DA_HEADS, DA_DV))

    lq = lam_qk.astype(jnp.float32)
    lam = jnp.exp(jnp.sum(lq[0] * lq[1])) - jnp.exp(jnp.sum(lq[2] * lq[3])) + lam_init
    ql, kl, vl = qkv(ul)
    qc, kc, vc = qkv(uc)
    ql, kl = _rope(ql, cos, sin), _rope(kl, cos, sin)
    k_all = jnp.concatenate([kl, kc], axis=1)
    v_all = jnp.concatenate([vl, vc], axis=1)
    B, T = ql.shape[:2]
    nb = T // Q_BLOCK
    qb = jnp.moveaxis(ql.reshape(B, nb, Q_BLOCK, DA_HEADS, 2, DA_DH), 1, 0)
    ob = lax.map(lambda qq: _diff_attn_core(qq, k_all, v_all, lam), qb)
    ol = jnp.moveaxis(ob, 0, 1).reshape(B, T, DA_HEADS, DA_DV)

    def post(o):
        Bo, To = o.shape[:2]
        return (_rmsnorm(o, head_g.reshape(DA_HEADS, DA_DV)) * (1.0 - lam_init)).reshape(Bo, To, DA_V_W)

    oc = post(_diff_attn_core(qc, kc, vc, lam)) if need_ctx else None
    return post(ol), oc


def _fourier(u):
    B, T, _ = u.shape
    z = u.astype(jnp.float32).reshape(B, T, FN_GROUPS, FN_GC)
    y = jnp.fft.fftn(z, axes=(1, 3), norm='ortho').real
    return y.reshape(B, T, FN_W).astype(u.dtype)


def _merge(ym, yd, yf, g_pre, w_br_ml, w_br_da, w_br_fn, w_out):
    gm, gd, gf = jnp.split(jax.nn.sigmoid(g_pre), N_BRANCH, axis=-1)
    y = gm * (ym @ w_br_ml) + gd * (yd @ w_br_da) + gf * (yf @ w_br_fn)
    return y @ w_out


def _mixer(hl, hc, w_in, ml_gate_b, ml_head_g, da_lam, da_head_g, w_br_ml, w_br_da, w_br_fn, w_out,
           cos, sin, lam_init, need_ctx):
    ul = _split_cols(hl @ w_in)
    uc = _split_cols(hc @ w_in)
    ml_l, ml_c = _mlstm_branch(ul, uc, ml_gate_b, ml_head_g)
    da_l, da_c = _diff_attn_branch(ul, uc, da_lam, da_head_g, cos, sin, lam_init, need_ctx)
    yl = _merge(ml_l, da_l, _fourier(ul[8]), ul[9], w_br_ml, w_br_da, w_br_fn, w_out)
    yc = _merge(ml_c, da_c, _fourier(uc[8]), uc[9], w_br_ml, w_br_da, w_br_fn, w_out) if need_ctx else None
    return yl, yc


def _swiglu(h, w_in, w_out):
    a, b = jnp.split(h @ w_in, 2, axis=-1)
    return (jax.nn.silu(a) * b) @ w_out


def setup_inputs(seed: int = 0) -> dict:
    key = jax.random.key(seed)
    ks = jax.random.split(key, 20)
    f32 = jnp.float32
    D = D_MODEL

    def nrm(k, shape, s):
        return jax.random.normal(k, shape, f32) * s

    f_mask = jnp.array([0.0, 1.0, 0.0, 1.0], f32)[None, :, None]
    f_bias = jnp.linspace(3.0, 6.0, ML_HEADS, dtype=f32)[None, None, :]
    ml_gate_b = (nrm(ks[8], (DEPTH, 4, ML_HEADS), 0.1) + f_mask * f_bias).reshape(DEPTH, 4 * ML_HEADS)
    return {
        'x': nrm(ks[0], (BATCH, SEQ, D), 1.0),
        'c': nrm(ks[1], (BATCH, D), 1.0),
        'ctx': nrm(ks[2], (BATCH, CTX_LEN, D), 1.0),
        'c_ctx': nrm(ks[3], (D,), 1.0),
        'w_ada': nrm(ks[4], (DEPTH, D, 6 * D), 0.5 * D ** -0.5),
        'b_ada': nrm(ks[5], (DEPTH, 6 * D), 0.02),
        'norm_g': 1.0 + nrm(ks[6], (DEPTH, 2, D), 0.02),
        'w_in': nrm(ks[7], (DEPTH, D, D_IN), D ** -0.5),
        'ml_gate_b': ml_gate_b,
        'ml_head_g': 1.0 + nrm(ks[9], (DEPTH, ML_W), 0.02),
        'da_lam': nrm(ks[10], (DEPTH, 4, DA_DH), 0.1),
        'da_head_g': 1.0 + nrm(ks[11], (DEPTH, DA_V_W), 0.02),
        'w_br_ml': nrm(ks[12], (DEPTH, ML_W, D), ML_W ** -0.5),
        'w_br_da': nrm(ks[13], (DEPTH, DA_V_W, D), DA_V_W ** -0.5),
        'w_br_fn': nrm(ks[14], (DEPTH, FN_W, D), FN_W ** -0.5),
        'w_out': nrm(ks[15], (DEPTH, D, D), D ** -0.5),
        'w_ffn_in': nrm(ks[16], (DEPTH, D, 2 * D_FF), D ** -0.5),
        'w_ffn_out': nrm(ks[17], (DEPTH, D_FF, D), D_FF ** -0.5),
        'final_g': 1.0 + nrm(ks[18], (D,), 0.02),
    }


def reference(x, c, ctx, c_ctx, w_ada, b_ada, norm_g, w_in, ml_gate_b, ml_head_g, da_lam, da_head_g,
              w_br_ml, w_br_da, w_br_fn, w_out, w_ffn_in, w_ffn_out, final_g):
    T = x.shape[1]
    ROWS = T // GRID_W
    cos, sin = _axial_rope(ROWS)
    s_lat = jax.nn.silu(c)
    s_ctx = jax.nn.silu(c_ctx)
    xl, xc = x, ctx
    for l in range(DEPTH):
        need_ctx = l < DEPTH - 1
        lam_init = 0.8 - 0.6 * math.exp(-0.3 * l)
        ml = jnp.split((s_lat @ w_ada[l] + b_ada[l])[:, None, :], 6, axis=-1)
        mc = jnp.split((s_ctx @ w_ada[l] + b_ada[l])[None, None, :], 6, axis=-1)
        hl = _modulate(_rmsnorm(xl, norm_g[l, 0]), ml[0], ml[1])
        hc = _modulate(_rmsnorm(xc, norm_g[l, 0]), mc[0], mc[1])
        yl, yc = _mixer(hl, hc, w_in[l], ml_gate_b[l], ml_head_g[l], da_lam[l], da_head_g[l],
                        w_br_ml[l], w_br_da[l], w_br_fn[l], w_out[l], cos, sin, lam_init, need_ctx)
        xl = xl + ml[2] * yl
        xl = xl + ml[5] * _swiglu(_modulate(_rmsnorm(xl, norm_g[l, 1]), ml[3], ml[4]), w_ffn_in[l], w_ffn_out[l])
        if need_ctx:
            xc = xc + mc[2] * yc
            xc = xc + mc[5] * _swiglu(_modulate(_rmsnorm(xc, norm_g[l, 1]), mc[3], mc[4]), w_ffn_in[l], w_ffn_out[l])
    return _rmsnorm(xl, final_g)
```

```cpp
#include <hip/hip_runtime.h>
#include <hip/hip_cooperative_groups.h>
#include <cstdio>
#include <cstdint>
namespace cg = cooperative_groups;

#define LAS __attribute__((address_space(3)))
typedef unsigned short bf16_t;
typedef short bf16x8 __attribute__((ext_vector_type(8)));
typedef float f32x4 __attribute__((ext_vector_type(4)));
typedef float f32x2 __attribute__((ext_vector_type(2)));
typedef unsigned u32x4 __attribute__((ext_vector_type(4)));
typedef unsigned u32x2 __attribute__((ext_vector_type(2)));
typedef LAS unsigned char* ldsp;

constexpr int DM = 1024, NB = 4, SEQ = 4096, CTXL = 256, DEPTH = 4;
constexpr int ML_ROWS = NB * SEQ;
constexpr int MC_ROWS = NB * CTXL;
constexpr int MROWS = ML_ROWS + MC_ROWS;
constexpr int DIN = 11280, DFF = 2816;
constexpr float EPS = 1e-6f;
constexpr int LDU = 9216;
constexpr int U_GP = 0, U_FN = 3072, U_DAK = 4096, U_DAQ = 5120, U_OG = 6144, U_MLQ = 7168, U_MLK = 8192;
constexpr int WIN_ROWS = 11520, WIN_MAIN = 9472, WIN_MLV = 9472, WIN_DAV = 10496;
constexpr int LDT = MROWS;
constexpr int NCH = 34;
constexpr float QSCALE = 0.125f * 1.4426950408889634f;

constexpr size_t MiB = 1u << 20;
constexpr size_t WS_WIN = 0;
constexpr size_t WS_WBR = WS_WIN + (size_t)WIN_ROWS * DM * 2;
constexpr size_t WS_WOUT = WS_WBR + 3 * (size_t)DM * DM * 2;
constexpr size_t WS_WF1 = WS_WOUT + (size_t)DM * DM * 2;
constexpr size_t WS_WF2 = WS_WF1 + (size_t)2 * DFF * DM * 2;
constexpr size_t WS_WEND = WS_WF2 + (size_t)DM * DFF * 2;
constexpr size_t WS_U = 52 * MiB;
constexpr size_t WS_TT = WS_U + (size_t)MROWS * LDU * 2;
constexpr size_t WS_XC = WS_TT + (size_t)2048 * LDT * 2;
constexpr size_t WS_AB = WS_XC + (size_t)MC_ROWS * DM * 4;
constexpr size_t WS_ATC = WS_AB + (size_t)NB * 1024 * 8192 * 2;
constexpr size_t WS_KT = WS_AB + (size_t)34 * MiB;
static_assert(WS_KT >= WS_AB + (size_t)MROWS * DM * 2 && WS_KT + (size_t)1024 * LDT * 2 <= WS_ATC + (size_t)NB * 1024 * 512 * 2, "KT overlay");
constexpr size_t WS_D = WS_ATC + (size_t)NB * 1024 * 512 * 2;
constexpr size_t WS_DC = WS_D + (size_t)4096 * 8192 * 2;
constexpr size_t WS_WC = WS_DC + (size_t)256 * 512 * 2;
constexpr size_t WS_ROPE = WS_WC + (size_t)512 * 256 * 2;
constexpr size_t WS_MODS = WS_ROPE + (size_t)4096 * 64 * 4;
constexpr size_t WS_G = WS_MODS + (size_t)DEPTH * 5 * 6144 * 4;
constexpr size_t WS_NST = WS_G + (size_t)MROWS * 16 * 4;
constexpr size_t WS_MST = WS_NST + (size_t)32 * NCH * 256 * 4;
constexpr size_t WS_CTR = WS_MST + 32 * NCH * 4;
constexpr size_t WS_BAR = WS_CTR + 256;
constexpr size_t WS_CT = ((WS_BAR + 3456 * 4 + 255) / 256) * 256;
constexpr size_t WS_END = WS_CT + (size_t)32 * NCH * 65536 * 2;
static_assert(WS_WEND <= WS_U, "weights fit");
static_assert((size_t)MROWS * DM * 4 <= (size_t)32 * NCH * 65536 * 2, "Y overlay fits");
static_assert((size_t)MROWS * DFF * 2 <= (size_t)MROWS * LDU * 2, "hidden overlay fits");

constexpr int LDS_BYTES = 155648;

__device__ __forceinline__ unsigned cvt_pk_bf16(float lo, float hi) { unsigned r; asm volatile("v_cvt_pk_bf16_f32 %0, %1, %2" : "=v"(r) : "v"(lo), "v"(hi)); return r; }
__device__ __forceinline__ float bf2f(bf16_t v) { return __uint_as_float((unsigned)v << 16); }
__device__ __forceinline__ float sigmoidf_(float x) { return 1.0f / (1.0f + __expf(-x)); }
__device__ __forceinline__ f32x4 mfma16(bf16x8 a, bf16x8 b, f32x4 c) { return __builtin_amdgcn_mfma_f32_16x16x32_bf16(a, b, c, 0, 0, 0); }
__device__ __forceinline__ float wave_sum(float v) {
#pragma unroll
    for (int o = 1; o < 64; o <<= 1) v += __shfl_xor(v, o);
    return v;
}

namespace pg8 {
constexpr int BM = 256, BK = 64, HALF = 128, HTB = HALF * BK * 2, STAGE_BYTES = 8 * HTB, NXCD = 8, WGM = 8;
__host__ __device__ __forceinline__ int lds_byte(int r, int c) { const int st = (r >> 4) * 2 + (c >> 5), rr = r & 15, cc = c & 31, ob = rr * 64 + cc * 2; return st * 1024 + (ob ^ (((ob >> 9) & 1) << 5)); }
__host__ __device__ __forceinline__ void stage_rc(int b, int& R, int& C) { const int st = b / 1024, sb = b % 1024, swz = sb ^ (((sb >> 9) & 1) << 5); R = (st >> 1) * 16 + swz / 64; C = (st & 1) * 32 + (swz % 64) / 2; }
__host__ __device__ __forceinline__ int perm32(int rho) { const int n = rho >> 4, i = rho & 15; return 8 * (i >> 2) + 4 * n + (i & 3); }

struct Unit { const char* A; const char* B; int pm, pn, job; };
struct Gemm { int lda, ldb, K; };

struct Sched {
    const char* A0; const char* B0; size_t tA, tB, s1A, s2A, s1B, s2B; int nM, nN, nj2, nwg, G, c; bool swz; bool fold;
    __device__ __forceinline__ void init(const void* A, const void* B, int lda, int ldb, int nM_, int nN_, int njobs, int nj2_, size_t s1A_, size_t s2A_, size_t s1B_, size_t s2B_, int G_, int c_, bool swz_) {
        A0 = (const char*)A; B0 = (const char*)B; tA = (size_t)BM * lda * 2; tB = (size_t)BM * ldb * 2; s1A = s1A_; s2A = s2A_; s1B = s1B_; s2B = s2B_;
        nM = nM_; nN = nN_; nj2 = nj2_; nwg = nM_ * nN_ * njobs; G = G_; c = c_; swz = swz_; fold = false;
    }
    __device__ __forceinline__ bool next(int i, Unit& u) const {
        const long L = (long)i * G + c; if (L >= nwg) return false;
        int wgid = (int)L, job = 0, pm, pn;
        if (swz) {
            { const int q = nwg / NXCD, r = nwg % NXCD, xcd = wgid % NXCD, off = wgid / NXCD; wgid = (xcd < r ? xcd * (q + 1) : r * (q + 1) + (xcd - r) * q) + off; }
            const int nig = WGM * nN, gid = wgid / nig, fm = gid * WGM, gsz = (nM - fm) < WGM ? (nM - fm) : WGM;
            pm = fm + ((wgid % nig) % gsz); pn = (wgid % nig) / gsz;
        } else {
            if (fold) { job = wgid / 17; const int rem = wgid - job * 17; pm = rem < 9 ? 0 : 1; pn = rem < 9 ? rem : rem - 1; }
            else { const int per = nM * nN; job = wgid / per; const int rem = wgid - job * per; pn = rem / nM; pm = rem - pn * nM; }
        }
        const int j1 = job / nj2, j2 = job - j1 * nj2;
        u.pm = pm; u.pn = pn; u.job = job;
        u.A = A0 + (size_t)j1 * s1A + (size_t)j2 * s2A + (size_t)pm * tA;
        u.B = B0 + (size_t)j1 * s1B + (size_t)j2 * s2B + (size_t)pn * tB;
        return true;
    }
};

template <class Epi>
__device__ __forceinline__ void gemm_phase(ldsp lds, const Gemm g, const Sched& S, const Epi& E) {
    int tid = threadIdx.x; asm volatile("" : "+v"(tid)); const int wid = __builtin_amdgcn_readfirstlane(tid >> 6), lane = tid & 63, wr = wid >> 2, wc = wid & 3, fr = lane & 15, fq = lane >> 4;
    int K = g.K; asm volatile("" : "+s"(K)); const int nt = K / BK;
    unsigned voffA[2], voffB[2];
#pragma unroll
    for (int i = 0; i < 2; ++i) { int R, C; stage_rc(tid * 16 + i * 8192, R, C); const int Rb = (R & ~31) + perm32(R & 31);
        voffA[i] = (unsigned)(R * g.lda + C) * 2u; voffB[i] = (unsigned)(Rb * g.ldb + C) * 2u; }
    const size_t kstep = (size_t)(BK * 2);
    const size_t hstepA = (size_t)HALF * g.lda * 2, hstepB = (size_t)HALF * g.ldb * 2;
    const unsigned ldsw = (unsigned)wid * 1024u;
    const int aoff = lds_byte(wr * 64 + fr, fq * 8), boff = lds_byte(wc * 32 + fr, fq * 8);
#define PG8_SA(b, h) (((b) * 2 + (h)) * HTB)
#define PG8_SB(b, h) ((4 + (b) * 2 + (h)) * HTB)
#define PG8_STAGE(bufoff, gbase, voff) do { _Pragma("unroll") for (int _i = 0; _i < 2; ++_i) \
        __builtin_amdgcn_global_load_lds((const unsigned*)((const char*)(gbase) + (voff)[_i]), (LAS unsigned*)(lds + (bufoff) + ldsw + _i * 8192), 16, 0, 0); } while (0)
#define PG8_LDA(dst, b, h) do { _Pragma("unroll") for (int m = 0; m < 4; ++m) _Pragma("unroll") for (int k = 0; k < 2; ++k) dst[m][k] = *(const LAS bf16x8*)(lds + PG8_SA(b, h) + aoff + m * 2048 + k * 1024); } while (0)
#define PG8_LDB(dst, b, h) do { _Pragma("unroll") for (int n = 0; n < 2; ++n) _Pragma("unroll") for (int k = 0; k < 2; ++k) dst[n][k] = *(const LAS bf16x8*)(lds + PG8_SB(b, h) + boff + n * 2048 + k * 1024); } while (0)
#define PG8_MMA(ai, bj, At, Bt) do { __builtin_amdgcn_s_setprio(1); _Pragma("unroll") for (int m = 0; m < 4; ++m) _Pragma("unroll") for (int n = 0; n < 2; ++n) _Pragma("unroll") for (int k = 0; k < 2; ++k) \
        acc[ai][bj][m][n] = __builtin_amdgcn_mfma_f32_16x16x32_bf16(Bt[n][k], At[m][k], acc[ai][bj][m][n], 0, 0, 0); __builtin_amdgcn_s_setprio(0); } while (0)
#define PG8_WAIT_V(n) asm volatile("s_waitcnt vmcnt(" #n ")" ::: "memory")
#define PG8_WAIT_L(n) asm volatile("s_waitcnt lgkmcnt(" #n ")" ::: "memory")
#define PG8_BAR __builtin_amdgcn_s_barrier()
#define PG8_SCHED __builtin_amdgcn_sched_barrier(0)
    Unit cur, nxt; int ui = 0;
    if (!S.next(0, cur)) return;
    f32x4 acc[2][2][4][2];
#pragma unroll
    for (int a = 0; a < 2; ++a)
#pragma unroll
        for (int b = 0; b < 2; ++b)
#pragma unroll
            for (int m = 0; m < 4; ++m)
#pragma unroll
                for (int n = 0; n < 2; ++n) acc[a][b][m][n] = (f32x4){0.f, 0.f, 0.f, 0.f};
    bf16x8 At[4][2], B0[2][2], B1[2][2];
    const char* cA = cur.A; const char* cB = cur.B;
    PG8_STAGE(PG8_SB(0, 0), cB, voffB); PG8_STAGE(PG8_SB(0, 1), cB + hstepB, voffB); PG8_STAGE(PG8_SA(0, 0), cA, voffA); PG8_STAGE(PG8_SA(0, 1), cA + hstepA, voffA);
    if (wr == 1) PG8_BAR;
    PG8_WAIT_V(2); PG8_BAR;
    PG8_STAGE(PG8_SB(1, 0), cB + kstep, voffB); PG8_STAGE(PG8_SA(1, 0), cA + kstep, voffA); PG8_STAGE(PG8_SB(1, 1), cB + hstepB + kstep, voffB);
    PG8_WAIT_V(6); PG8_BAR;
    for (;;) {
        const bool has_next = S.next(ui + 1, nxt);
        const char* nA = has_next ? nxt.A : cA; const char* nB = has_next ? nxt.B : cB;
#pragma unroll 1
        for (int t = 0; t < nt; t += 2) {
            const bool last = (t == nt - 2);
            const char* a1 = cA + (size_t)(t + 1) * kstep;
            const char* a2 = last ? nA : cA + (size_t)(t + 2) * kstep; const char* b2 = last ? nB : cB + (size_t)(t + 2) * kstep;
            const char* a3 = a2 + kstep; const char* b3 = b2 + kstep;
            PG8_LDB(B0, 0, 0); PG8_LDB(B1, 0, 1); PG8_SCHED; PG8_LDA(At, 0, 0); PG8_STAGE(PG8_SA(1, 1), a1 + hstepA, voffA);
            PG8_WAIT_V(8); PG8_WAIT_L(0); PG8_BAR; PG8_MMA(0, 0, At, B0); PG8_MMA(0, 1, At, B1); PG8_BAR; PG8_SCHED;
            PG8_LDA(At, 0, 1); PG8_STAGE(PG8_SB(0, 0), b2, voffB); PG8_STAGE(PG8_SB(0, 1), b2 + hstepB, voffB); PG8_STAGE(PG8_SA(0, 0), a2, voffA);
            PG8_WAIT_V(8); PG8_WAIT_L(0); PG8_BAR; PG8_MMA(1, 0, At, B0); PG8_MMA(1, 1, At, B1); PG8_BAR; PG8_SCHED;
            PG8_LDB(B0, 1, 0); PG8_LDB(B1, 1, 1); PG8_SCHED; PG8_LDA(At, 1, 0); PG8_STAGE(PG8_SA(0, 1), a2 + hstepA, voffA);
            PG8_WAIT_V(8); PG8_WAIT_L(0); PG8_BAR; PG8_MMA(0, 0, At, B0); PG8_MMA(0, 1, At, B1); PG8_BAR; PG8_SCHED;
            PG8_LDA(At, 1, 1); PG8_STAGE(PG8_SB(1, 0), b3, voffB); PG8_STAGE(PG8_SB(1, 1), b3 + hstepB, voffB); PG8_STAGE(PG8_SA(1, 0), a3, voffA);
            PG8_WAIT_V(8); PG8_WAIT_L(0); PG8_BAR; PG8_MMA(1, 0, At, B0); PG8_MMA(1, 1, At, B1); PG8_BAR; PG8_SCHED;
        }
        if (wr == 0) PG8_BAR;
        E(acc, cur, wr, wc, fr, fq);
        if (!has_next) break;
#pragma unroll
        for (int a = 0; a < 2; ++a)
#pragma unroll
            for (int b = 0; b < 2; ++b)
#pragma unroll
                for (int m = 0; m < 4; ++m)
#pragma unroll
                    for (int n = 0; n < 2; ++n) acc[a][b][m][n] = (f32x4){0.f, 0.f, 0.f, 0.f};
        cur = nxt; cA = nA; cB = nB; ++ui;
        if (wr == 1) PG8_BAR;
    }
    PG8_WAIT_V(0);
    PG8_BAR;
#undef PG8_SA
#undef PG8_SB
#undef PG8_STAGE
#undef PG8_LDA
#undef PG8_LDB
#undef PG8_MMA
#undef PG8_WAIT_V
#undef PG8_WAIT_L
#undef PG8_BAR
#undef PG8_SCHED
}
}
using pg8::Unit;

#define EPI_BEGIN(acc, wr, wc, fr, fq) \
    _Pragma("unroll") for (int ai = 0; ai < 2; ++ai) _Pragma("unroll") for (int m = 0; m < 4; ++m) _Pragma("unroll") for (int bj = 0; bj < 2; ++bj) { \
        const int rt = ai * 128 + wr * 64 + m * 16 + fr, ct = bj * 128 + wc * 32 + fq * 8; f32x4 v0 = acc[ai][bj][m][0], v1 = acc[ai][bj][m][1];
#define EPI_END }

__device__ __forceinline__ u32x4 pack8(f32x4 v0, f32x4 v1) { u32x4 w; w.x = cvt_pk_bf16(v0[0], v0[1]); w.y = cvt_pk_bf16(v0[2], v0[3]); w.z = cvt_pk_bf16(v1[0], v1[1]); w.w = cvt_pk_bf16(v1[2], v1[3]); return w; }

struct EpiInproj {
    bf16_t* U; float* G; const float* gate_b; const float* rope;
    __device__ __forceinline__ void operator()(const f32x4 (&acc)[2][2][4][2], const Unit& u, int wr, int wc, int fr, int fq) const {
        const int row0 = u.pm * 256;
        if (u.pn == 0) {
            if (wc == 0 && fq < 2) {
                f32x4 b0 = *(const f32x4*)(gate_b + 8 * fq), b1 = *(const f32x4*)(gate_b + 8 * fq + 4);
#pragma unroll
                for (int ai = 0; ai < 2; ++ai)
#pragma unroll
                    for (int m = 0; m < 4; ++m) { const int row = row0 + ai * 128 + wr * 64 + m * 16 + fr;
                        *(f32x4*)(G + (size_t)row * 16 + 8 * fq) = acc[ai][0][m][0] + b0; *(f32x4*)(G + (size_t)row * 16 + 8 * fq + 4) = acc[ai][0][m][1] + b1; }
            }
            return;
        }
        const int ucol0 = (u.pn - 1) * 256;
        const int seg = ucol0 < U_FN ? 0 : (ucol0 >> 10);
        const bool latent = row0 < ML_ROWS;
        EPI_BEGIN(acc, wr, wc, fr, fq) {
            const int row = row0 + rt, col = ucol0 + ct;
            if (seg == 0 || seg == 6) {
#pragma unroll
                for (int j = 0; j < 4; ++j) { v0[j] = sigmoidf_(v0[j]); v1[j] = sigmoidf_(v1[j]); }
            } else if (seg == 4 || seg == 5) {
                if (latent) {
                    const int t = row & (SEQ - 1), ib = (col & 63) >> 1;
                    const f32x4 cs0 = *(const f32x4*)(rope + ((size_t)t * 32 + ib) * 2), cs1 = *(const f32x4*)(rope + ((size_t)t * 32 + ib) * 2 + 4);
                    f32x4 w0, w1;
                    w0[0] = v0[0] * cs0[0] - v0[1] * cs0[1]; w0[1] = v0[0] * cs0[1] + v0[1] * cs0[0];
                    w0[2] = v0[2] * cs0[2] - v0[3] * cs0[3]; w0[3] = v0[2] * cs0[3] + v0[3] * cs0[2];
                    w1[0] = v1[0] * cs1[0] - v1[1] * cs1[1]; w1[1] = v1[0] * cs1[1] + v1[1] * cs1[0];
                    w1[2] = v1[2] * cs1[2] - v1[3] * cs1[3]; w1[3] = v1[2] * cs1[3] + v1[3] * cs1[2];
                    v0 = w0; v1 = w1;
                }
                if (seg == 5) { v0 = v0 * QSCALE; v1 = v1 * QSCALE; }
            } else if (seg == 8) { v0 = v0 * 0.0625f; v1 = v1 * 0.0625f; }
            *(u32x4*)(U + (size_t)row * LDU + col) = pack8(v0, v1);
        } EPI_END
    }
};
struct EpiTT {
    bf16_t* TT; bf16_t* KT;
    __device__ __forceinline__ void operator()(const f32x4 (&acc)[2][2][4][2], const Unit& u, int wr, int wc, int fr, int fq) const {
        bf16_t* base = u.pm < 4 ? KT + (size_t)(u.pm * 256) * LDT : TT + (size_t)((u.pm - 4) * 256) * LDT;
        const float sc = u.pm < 4 ? 0.0625f : 1.0f;
        if (u.pm < 8) {
            EPI_BEGIN(acc, wr, wc, fr, fq) { *(u32x4*)(base + (size_t)rt * LDT + u.pn * 256 + ct) = pack8(v0 * sc, v1 * sc); } EPI_END
        } else {
            EPI_BEGIN(acc, wr, wc, fr, fq) {
                const int m8 = (ct >> 3) & 3, hh = m8 >> 1, q0 = 2 * (m8 & 1);
                bf16_t* p = base + (size_t)rt * LDT + u.pn * 256 + (ct & ~31);
                u32x2 w0; w0.x = cvt_pk_bf16(v0[0], v0[1]); w0.y = cvt_pk_bf16(v0[2], v0[3]);
                u32x2 w1; w1.x = cvt_pk_bf16(v1[0], v1[1]); w1.y = cvt_pk_bf16(v1[2], v1[3]);
                *(u32x2*)(p + 8 * q0 + 4 * hh) = w0; *(u32x2*)(p + 8 * (q0 + 1) + 4 * hh) = w1;
            } EPI_END
        }
    }
};
struct EpiF1 {
    bf16_t* AT; int Tn;
    __device__ __forceinline__ void operator()(const f32x4 (&acc)[2][2][4][2], const Unit& u, int wr, int wc, int fr, int fq) const {
        const int b = u.job >> 2, g = u.job & 3;
        EPI_BEGIN(acc, wr, wc, fr, fq) { *(u32x4*)(AT + ((size_t)((b * 1024 + 256 * g + rt) * 2 + u.pm)) * Tn + u.pn * 256 + ct) = pack8(v0, v1); } EPI_END
    }
};
struct EpiF1Fold {
    bf16_t* AT;
    __device__ __forceinline__ void operator()(const f32x4 (&acc)[2][2][4][2], const Unit& u, int wr, int wc, int fr, int fq) const {
        const int b = u.job >> 2, g = u.job & 3;
        EPI_BEGIN(acc, wr, wc, fr, fq) {
            bf16_t* p = AT + (size_t)(b * 1024 + 256 * g + rt) * 4096 + u.pn * 256 + ct;
            const u32x4 w = pack8(v0, v1);
            if (u.pn != 8) *(u32x4*)p = w;
            else if (u.pm == 0) { if (ct == 0) p[0] = (bf16_t)(w.x & 0xffffu); }
            else { if (ct != 0) *(u32x4*)p = w;
                   else { p[1] = (bf16_t)(w.x >> 16); *(unsigned*)(p + 2) = w.y; *(unsigned*)(p + 4) = w.z; *(unsigned*)(p + 6) = w.w; } }
        } EPI_END
    }
};
struct EpiF2 {
    bf16_t* U; int rowbase, Tn;
    __device__ __forceinline__ void operator()(const f32x4 (&acc)[2][2][4][2], const Unit& u, int wr, int wc, int fr, int fq) const {
        EPI_BEGIN(acc, wr, wc, fr, fq) { *(u32x4*)(U + (size_t)(rowbase + u.job * Tn + u.pm * 256 + rt) * LDU + U_FN + u.pn * 256 + ct) = pack8(v0, v1); } EPI_END
    }
};
template <int PASS> struct EpiMerge {
    const bf16_t* U; bf16_t* Y; bf16_t* AB;
    __device__ __forceinline__ void operator()(const f32x4 (&acc)[2][2][4][2], const Unit& u, int wr, int wc, int fr, int fq) const {
        EPI_BEGIN(acc, wr, wc, fr, fq) {
            const int row = u.pm * 256 + rt, col = u.pn * 256 + ct;
            const u32x4 gw = *(const u32x4*)(U + (size_t)row * LDU + U_GP + 1024 * PASS + col);
            f32x4 g0, g1;
            g0[0] = __uint_as_float(gw.x << 16); g0[1] = __uint_as_float(gw.x & 0xffff0000u); g0[2] = __uint_as_float(gw.y << 16); g0[3] = __uint_as_float(gw.y & 0xffff0000u);
            g1[0] = __uint_as_float(gw.z << 16); g1[1] = __uint_as_float(gw.z & 0xffff0000u); g1[2] = __uint_as_float(gw.w << 16); g1[3] = __uint_as_float(gw.w & 0xffff0000u);
            v0 = v0 * g0; v1 = v1 * g1;
            bf16_t* yp = Y + (size_t)row * DM + col;
            if (PASS > 0) { const u32x4 yw = *(const u32x4*)yp;
                v0[0] += __uint_as_float(yw.x << 16); v0[1] += __uint_as_float(yw.x & 0xffff0000u); v0[2] += __uint_as_float(yw.y << 16); v0[3] += __uint_as_float(yw.y & 0xffff0000u);
                v1[0] += __uint_as_float(yw.z << 16); v1[1] += __uint_as_float(yw.z & 0xffff0000u); v1[2] += __uint_as_float(yw.w << 16); v1[3] += __uint_as_float(yw.w & 0xffff0000u); }
            if (PASS < 2) *(u32x4*)yp = pack8(v0, v1);
            else *(u32x4*)(AB + (size_t)row * DM + col) = pack8(v0, v1);
        } EPI_END
    }
};
struct EpiResid {
    const float* srcL; const float* srcC; float* dstL; float* dstC; const float* gate;
    __device__ __forceinline__ void operator()(const f32x4 (&acc)[2][2][4][2], const Unit& u, int wr, int wc, int fr, int fq) const {
        const bool lat = u.pm < 64; const int s = lat ? (u.pm >> 4) : 4;
        const float* src = lat ? srcL + (size_t)u.pm * 256 * DM : srcC + (size_t)(u.pm - 64) * 256 * DM;
        float* dst = lat ? dstL + (size_t)u.pm * 256 * DM : dstC + (size_t)(u.pm - 64) * 256 * DM;
        const float* gp = gate + (size_t)s * 6144;
        EPI_BEGIN(acc, wr, wc, fr, fq) {
            const int col = u.pn * 256 + ct; const size_t off = (size_t)rt * DM + col;
            const f32x4 g0 = *(const f32x4*)(gp + col), g1 = *(const f32x4*)(gp + col + 4);
            *(f32x4*)(dst + off) = *(const f32x4*)(src + off) + g0 * v0; *(f32x4*)(dst + off + 4) = *(const f32x4*)(src + off + 4) + g1 * v1;
        } EPI_END
    }
};
struct EpiResidCtxHalf {
    float* dstC; float* part; const float* gate;
    __device__ __forceinline__ void operator()(const f32x4 (&acc)[2][2][4][2], const Unit& u, int wr, int wc, int fr, int fq) const {
        float* dst = (u.job == 0 ? dstC : part) + (size_t)u.pm * 256 * DM;
        EPI_BEGIN(acc, wr, wc, fr, fq) {
            const int col = u.pn * 256 + ct; float* p = dst + (size_t)rt * DM + col;
            const f32x4 g0 = *(const f32x4*)(gate + col), g1 = *(const f32x4*)(gate + col + 4);
            if (u.job == 0) { *(f32x4*)p = *(const f32x4*)p + g0 * v0; *(f32x4*)(p + 4) = *(const f32x4*)(p + 4) + g1 * v1; }
            else { *(f32x4*)p = g0 * v0; *(f32x4*)(p + 4) = g1 * v1; }
        } EPI_END
    }
};
struct EpiMergeCtx {
    const bf16_t* U; float* Yc; int pass;
    __device__ __forceinline__ void operator()(const f32x4 (&acc)[2][2][4][2], const Unit& u, int wr, int wc, int fr, int fq) const {
        EPI_BEGIN(acc, wr, wc, fr, fq) {
            const int row = u.pm * 256 + rt, col = u.pn * 256 + ct;
            const u32x4 gw = *(const u32x4*)(U + (size_t)(ML_ROWS + row) * LDU + U_GP + 1024 * pass + col);
            f32x4 g0, g1;
            g0[0] = __uint_as_float(gw.x << 16); g0[1] = __uint_as_float(gw.x & 0xffff0000u); g0[2] = __uint_as_float(gw.y << 16); g0[3] = __uint_as_float(gw.y & 0xffff0000u);
            g1[0] = __uint_as_float(gw.z << 16); g1[1] = __uint_as_float(gw.z & 0xffff0000u); g1[2] = __uint_as_float(gw.w << 16); g1[3] = __uint_as_float(gw.w & 0xffff0000u);
            float* yp = Yc + (size_t)row * DM + col;
            *(f32x4*)yp = v0 * g0; *(f32x4*)(yp + 4) = v1 * g1;
        } EPI_END
    }
};
struct EpiSwiglu {
    bf16_t* H;
    __device__ __forceinline__ void operator()(const f32x4 (&acc)[2][2][4][2], const Unit& u, int wr, int wc, int fr, int fq) const {
#pragma unroll
        for (int ai = 0; ai < 2; ++ai)
#pragma unroll
            for (int m = 0; m < 4; ++m) {
                const int row = u.pm * 256 + ai * 128 + wr * 64 + m * 16 + fr, col = u.pn * 128 + wc * 32 + fq * 8;
                f32x4 h0, h1;
#pragma unroll
                for (int j = 0; j < 4; ++j) { const float a0 = acc[ai][0][m][0][j], a1 = acc[ai][0][m][1][j];
                    h0[j] = a0 * sigmoidf_(a0) * acc[ai][1][m][0][j]; h1[j] = a1 * sigmoidf_(a1) * acc[ai][1][m][1][j]; }
                *(u32x4*)(H + (size_t)row * DFF + col) = pack8(h0, h1);
            }
    }
};

__device__ __forceinline__ void norm_mod_row(const float* xr, const float* g, const float* shift, const float* scale, bf16_t* orow, int lane, const float* part = nullptr, float* xw = nullptr) {
    f32x4 v[4]; float s = 0.f;
#pragma unroll
    for (int j = 0; j < 4; ++j) { v[j] = *(const f32x4*)(xr + 4 * lane + 256 * j);
        if (part) { v[j] = v[j] + *(const f32x4*)(part + 4 * lane + 256 * j); *(f32x4*)(xw + 4 * lane + 256 * j) = v[j]; }
        s += (v[j][0] * v[j][0] + v[j][1] * v[j][1]) + (v[j][2] * v[j][2] + v[j][3] * v[j][3]); }
    const float rn = 1.0f / sqrtf(wave_sum(s) * (1.0f / DM) + EPS);
#pragma unroll
    for (int j = 0; j < 4; ++j) { const int c = 4 * lane + 256 * j;
        const f32x4 gg = *(const f32x4*)(g + c), sh = *(const f32x4*)(shift + c), sc = *(const f32x4*)(scale + c);
        f32x4 y = v[j] * rn * gg; y = y * (sc + 1.0f) + sh;
        u32x2 w; w.x = cvt_pk_bf16(y[0], y[1]); w.y = cvt_pk_bf16(y[2], y[3]); *(u32x2*)(orow + c) = w; }
}
__device__ __forceinline__ int dst_row(int perm, int n) {
    if (perm == 1) { const int d = n & 63; return (n & ~63) + (d < 32 ? 2 * d : 2 * (d - 32) + 1); }
    if (perm == 2) { const int j = n < DFF ? n : n - DFF; return 256 * (j >> 7) + (n < DFF ? 0 : 128) + (j & 127); }
    return n;
}
__device__ __forceinline__ void transpose_item(const float* W, int ldn, int src_off, int width, bf16_t* WT, int Kd, int row_off, int perm, LAS float* scr, int kb, int nb, int lane) {
    const int k0 = 64 * kb, n0 = 32 * nb; const bool okc = (n0 + (lane & 31)) < width;
#pragma unroll
    for (int i = 0; i < 32; ++i) { const int kk = 2 * i + (lane >> 5); scr[kk * 33 + (lane & 31)] = okc ? W[(size_t)(k0 + kk) * ldn + src_off + n0 + (lane & 31)] : 0.f; }
    asm volatile("s_waitcnt lgkmcnt(0)" ::: "memory");
    const int c = lane & 7;
#pragma unroll
    for (int j = 0; j < 4; ++j) { const int n = (lane >> 3) + 8 * j; const LAS float* s = scr + (8 * c) * 33 + n;
        u32x4 o; o.x = cvt_pk_bf16(s[0 * 33], s[1 * 33]); o.y = cvt_pk_bf16(s[2 * 33], s[3 * 33]); o.z = cvt_pk_bf16(s[4 * 33], s[5 * 33]); o.w = cvt_pk_bf16(s[6 * 33], s[7 * 33]);
        if (n0 + n < width) *(u32x4*)(WT + (size_t)(row_off + dst_row(perm, n0 + n)) * Kd + k0 + 8 * c) = o; }
    asm volatile("s_waitcnt lgkmcnt(0)" ::: "memory");
}

__device__ __forceinline__ float xmax16(float v) { auto r = __builtin_amdgcn_permlane16_swap(__float_as_uint(v), __float_as_uint(v), false, false); return fmaxf(__uint_as_float(r[0]), __uint_as_float(r[1])); }
__device__ __forceinline__ float xmax32(float v) { auto r = __builtin_amdgcn_permlane32_swap(__float_as_uint(v), __float_as_uint(v), false, false); return fmaxf(__uint_as_float(r[0]), __uint_as_float(r[1])); }
__device__ __forceinline__ float xsum16(float v) { auto r = __builtin_amdgcn_permlane16_swap(__float_as_uint(v), __float_as_uint(v), false, false); return __uint_as_float(r[0]) + __uint_as_float(r[1]); }
__device__ __forceinline__ float xsum32(float v) { auto r = __builtin_amdgcn_permlane32_swap(__float_as_uint(v), __float_as_uint(v), false, false); return __uint_as_float(r[0]) + __uint_as_float(r[1]); }
__device__ __forceinline__ float max3f(float a, float b, float c) { float r; asm("v_max3_f32 %0, %1, %2, %3" : "=v"(r) : "v"(a), "v"(b), "v"(c)); return r; }
__device__ __forceinline__ float max2f(float a, float b) { float r; asm("v_max_f32_e32 %0, %1, %2" : "=v"(r) : "v"(a), "v"(b)); return r; }
__device__ __forceinline__ float xmax16a(float v) { auto r = __builtin_amdgcn_permlane16_swap(__float_as_uint(v), __float_as_uint(v), false, false); return max2f(__uint_as_float(r[0]), __uint_as_float(r[1])); }
__device__ __forceinline__ float xmax32a(float v) { auto r = __builtin_amdgcn_permlane32_swap(__float_as_uint(v), __float_as_uint(v), false, false); return max2f(__uint_as_float(r[0]), __uint_as_float(r[1])); }
constexpr float ATT_THR = 8.0f;
constexpr int ATT_KP = 288, ATT_VP = 160, ATT_KB = 64 * ATT_KP, ATT_VB = 128 * ATT_VP, ATT_BUF = ATT_KB + ATT_VB;
#define SCHED_FENCE() __builtin_amdgcn_sched_barrier(0)
__device__ __forceinline__ void attn_vload(bf16x8 (&vf)[4], ldsp vb, int g, int r, int qq) {
#pragma unroll
    for (int i = 0; i < 4; ++i) { const int c = 2 * g + (i >> 1), u = i & 1;
        vf[i] = *(const LAS bf16x8*)(vb + (16 * c + r) * ATT_VP + (32 * u + 8 * qq) * 2); }
}
__device__ __forceinline__ void attn_vload_u(bf16x8 (&vf)[4], ldsp vb, int u, int hf, int r, int qq) {
#pragma unroll
    for (int i = 0; i < 4; ++i) vf[i] = *(const LAS bf16x8*)(vb + (16 * (4 * hf + i) + r) * ATT_VP + (32 * u + 8 * qq) * 2);
}
__device__ __forceinline__ void attn_tile(ldsp kb, int mapw, const bf16x8 (&qf)[2][2], f32x4 (&O)[2][8], f32x4 (&negm)[2], float (&lrun)[2], bool first, int r, int qq,
                                          const u32x4 (&KR)[2], const u32x4 (&VR)[2], ldsp kst, ldsp vst, bool do_store) {
    ldsp vb = kb + ATT_KB;
    bf16x8 pf[2][2];
    f32x4 s[2][4];
#pragma unroll
    for (int kt = 0; kt < 4; ++kt) {
        const bf16x8 k0 = *(const LAS bf16x8*)(kb + (16 * kt + r) * ATT_KP + (mapw * 64 + qq * 8) * 2);
        const bf16x8 k1 = *(const LAS bf16x8*)(kb + (16 * kt + r) * ATT_KP + (mapw * 64 + 32 + qq * 8) * 2);
#pragma unroll
        for (int mp = 0; mp < 2; ++mp) s[mp][kt] = mfma16(k1, qf[mp][1], mfma16(k0, qf[mp][0], negm[mp]));
    }
    asm volatile("s_nop 15" : "+v"(s[0][0]), "+v"(s[0][1]), "+v"(s[0][2]), "+v"(s[0][3]), "+v"(s[1][0]), "+v"(s[1][1]), "+v"(s[1][2]), "+v"(s[1][3]));
    float mxl[2];
#pragma unroll
    for (int mp = 0; mp < 2; ++mp) {
        float mx = max3f(s[mp][0][0], s[mp][0][1], s[mp][0][2]);
        mx = max3f(mx, s[mp][0][3], s[mp][1][0]); mx = max3f(mx, s[mp][1][1], s[mp][1][2]); mx = max3f(mx, s[mp][1][3], s[mp][2][0]);
        mx = max3f(mx, s[mp][2][1], s[mp][2][2]); mx = max3f(mx, s[mp][2][3], s[mp][3][0]); mx = max3f(mx, s[mp][3][1], s[mp][3][2]); mxl[mp] = max2f(mx, s[mp][3][3]);
    }
    if (first || __any(max2f(mxl[0], mxl[1]) > ATT_THR)) {
#pragma unroll
        for (int mp = 0; mp < 2; ++mp) {
            const float mx = xmax32a(xmax16a(mxl[mp]));
            const float dl = first ? mx : fmaxf(mx, 0.f);
            const float al = __builtin_amdgcn_exp2f(-dl); lrun[mp] *= al;
            negm[mp] = negm[mp] - dl;
#pragma unroll
            for (int c = 0; c < 8; ++c) O[mp][c] = O[mp][c] * al;
#pragma unroll
            for (int kt = 0; kt < 4; ++kt) s[mp][kt] = s[mp][kt] - dl;
        }
    }
    if (do_store) {
        *(LAS u32x4*)kst = KR[0]; *(LAS u32x4*)(kst + 32 * ATT_KP) = KR[1]; *(LAS u32x4*)vst = VR[0]; *(LAS u32x4*)(vst + 64 * ATT_VP) = VR[1]; }
#pragma unroll
    for (int mp = 0; mp < 2; ++mp) {
        float ps = 0.f;
#pragma unroll
        for (int kt = 0; kt < 2; ++kt)
#pragma unroll
            for (int j = 0; j < 4; ++j) { s[mp][kt][j] = __builtin_amdgcn_exp2f(s[mp][kt][j]); ps += s[mp][kt][j]; }
        lrun[mp] += ps;
        u32x4 w; w.x = cvt_pk_bf16(s[mp][0][0], s[mp][0][1]); w.y = cvt_pk_bf16(s[mp][0][2], s[mp][0][3]); w.z = cvt_pk_bf16(s[mp][1][0], s[mp][1][1]); w.w = cvt_pk_bf16(s[mp][1][2], s[mp][1][3]);
        pf[mp][0] = __builtin_bit_cast(bf16x8, w);
    }
#define ATT_VL2(VF, u, g2) do { _Pragma("unroll") for (int i = 0; i < 2; ++i) VF[i] = *(const LAS bf16x8*)(vb + (16 * (2 * (g2) + i) + r) * ATT_VP + (32 * (u) + 8 * qq) * 2); } while (0)
#define ATT_PV2(VF, u, g2) do { _Pragma("unroll") for (int i = 0; i < 2; ++i) { const int c = 2 * (g2) + i; \
        O[0][c] = mfma16(VF[i], pf[0][u], O[0][c]); O[1][c] = mfma16(VF[i], pf[1][u], O[1][c]); } } while (0)
#define ATT_EXP2ND(kt) do { _Pragma("unroll") for (int mp = 0; mp < 2; ++mp) { float t_ = 0.f; _Pragma("unroll") for (int j = 0; j < 4; ++j) { s[mp][kt][j] = __builtin_amdgcn_exp2f(s[mp][kt][j]); t_ += s[mp][kt][j]; } lrun[mp] += t_; } } while (0)
    bf16x8 va[2], vb2[2];
    ATT_VL2(va, 0, 0);
    SCHED_FENCE(); ATT_VL2(vb2, 0, 1); SCHED_FENCE(); ATT_PV2(va, 0, 0); ATT_EXP2ND(2);
    SCHED_FENCE(); ATT_VL2(va, 0, 2); SCHED_FENCE(); ATT_PV2(vb2, 0, 1); ATT_EXP2ND(3);
#pragma unroll
    for (int mp = 0; mp < 2; ++mp) {
        u32x4 w; w.x = cvt_pk_bf16(s[mp][2][0], s[mp][2][1]); w.y = cvt_pk_bf16(s[mp][2][2], s[mp][2][3]); w.z = cvt_pk_bf16(s[mp][3][0], s[mp][3][1]); w.w = cvt_pk_bf16(s[mp][3][2], s[mp][3][3]);
        pf[mp][1] = __builtin_bit_cast(bf16x8, w); }
    SCHED_FENCE(); ATT_VL2(vb2, 0, 3); SCHED_FENCE(); ATT_PV2(va, 0, 2);
    SCHED_FENCE(); ATT_VL2(va, 1, 0); SCHED_FENCE(); ATT_PV2(vb2, 0, 3);
    SCHED_FENCE(); ATT_VL2(vb2, 1, 1); SCHED_FENCE(); ATT_PV2(va, 1, 0);
    SCHED_FENCE(); ATT_VL2(va, 1, 2); SCHED_FENCE(); ATT_PV2(vb2, 1, 1);
    SCHED_FENCE(); ATT_VL2(vb2, 1, 3); SCHED_FENCE(); ATT_PV2(va, 1, 2);
    SCHED_FENCE(); ATT_PV2(vb2, 1, 3); SCHED_FENCE();
#undef ATT_VL2
#undef ATT_PV2
#undef ATT_EXP2ND
}
__device__ __forceinline__ void attn_unit(ldsp lds, bf16_t* U, const bf16_t* TT, const float* hg, float lam, float post, int h, int qrow0, int seg0, int n0, int seg1, int n1) {
    int tid = threadIdx.x; asm volatile("" : "+v"(tid)); const int lane = tid & 63, wv = tid >> 6, r = lane & 15, qq = lane >> 4;
    bf16x8 qf[2][2];
    const int mapw = __builtin_amdgcn_readfirstlane(wv >> 2), wq = wv & 3;
#pragma unroll
    for (int mp = 0; mp < 2; ++mp)
#pragma unroll
        for (int ks = 0; ks < 2; ++ks) qf[mp][ks] = *(const bf16x8*)(U + (size_t)(qrow0 + 32 * wq + 16 * mp + r) * LDU + U_DAQ + h * 128 + mapw * 64 + ks * 32 + qq * 8);
    f32x4 O[2][8]; f32x4 negm[2]; float lrun[2];
#pragma unroll
    for (int mp = 0; mp < 2; ++mp) { negm[mp] = (f32x4){0.f, 0.f, 0.f, 0.f}; lrun[mp] = 0.f;
#pragma unroll
        for (int c = 0; c < 8; ++c) O[mp][c] = (f32x4){0.f, 0.f, 0.f, 0.f}; }
    const int NT = n0 + n1;
    u32x4 kA[2], vA[2], kB[2], vB[2];
    const int krow_l = tid >> 4, kcv = tid & 15, vrow_l = tid >> 3, vcv = tid & 7;
    const bf16_t* kbase = U + (size_t)krow_l * LDU + U_DAK + h * 128 + kcv * 8;
    const bf16_t* vbase = TT + (size_t)(1024 + h * 128 + vrow_l) * LDT + vcv * 8;
#define ATT_LOAD(t, KR, VR) do { const int kr0 = (t) < n0 ? seg0 + 64 * (t) : seg1 + 64 * ((t) - n0); \
        KR[0] = *(const u32x4*)(kbase + (size_t)kr0 * LDU); KR[1] = *(const u32x4*)(kbase + (size_t)(kr0 + 32) * LDU); \
        VR[0] = *(const u32x4*)(vbase + kr0); VR[1] = *(const u32x4*)(vbase + (size_t)64 * LDT + kr0); } while (0)
#define ATT_STORE(buf, KR, VR) do { ldsp kb_ = lds + (buf) * ATT_BUF; ldsp vb_ = kb_ + ATT_KB; \
        *(LAS u32x4*)(kb_ + krow_l * ATT_KP + kcv * 16) = KR[0]; *(LAS u32x4*)(kb_ + (krow_l + 32) * ATT_KP + kcv * 16) = KR[1]; \
        *(LAS u32x4*)(vb_ + vrow_l * ATT_VP + vcv * 16) = VR[0]; *(LAS u32x4*)(vb_ + (vrow_l + 64) * ATT_VP + vcv * 16) = VR[1]; } while (0)
    __syncthreads();
    ATT_LOAD(0, kA, vA); ATT_LOAD(1, kB, vB); ATT_STORE(0, kA, vA); __syncthreads();
#pragma unroll 1
    for (int t = 0; t < NT; t += 2) {
        if (t + 2 < NT) ATT_LOAD(t + 2, kA, vA);
        attn_tile(lds, mapw, qf, O, negm, lrun, t == 0, r, qq, kB, vB, lds + ATT_BUF + krow_l * ATT_KP + kcv * 16, lds + ATT_BUF + ATT_KB + vrow_l * ATT_VP + vcv * 16, true);
        __syncthreads();
        if (t + 3 < NT) ATT_LOAD(t + 3, kB, vB);
        attn_tile(lds + ATT_BUF, mapw, qf, O, negm, lrun, false, r, qq, kA, vA, lds + krow_l * ATT_KP + kcv * 16, lds + ATT_KB + vrow_l * ATT_VP + vcv * 16, t + 2 < NT);
        __syncthreads();
    }
#undef ATT_LOAD
#undef ATT_STORE
    {
        LAS f32x4* X = (LAS f32x4*)lds;
#pragma unroll
        for (int rg = 0; rg < 2; ++rg) {
            const float l = xsum32(xsum16(lrun[rg]));
            const float sc = (mapw ? lam : 1.0f) / l;
#pragma unroll
            for (int c = 0; c < 8; ++c) { O[rg][c] = O[rg][c] * sc; if (mapw) X[((wq * 2 + rg) * 8 + c) * 64 + lane] = O[rg][c]; }
        }
        __syncthreads();
        if (mapw == 0) {
#pragma unroll
            for (int rg = 0; rg < 2; ++rg) {
                float ss = 0.f;
#pragma unroll
                for (int c = 0; c < 8; ++c) { O[rg][c] = O[rg][c] - X[((wq * 2 + rg) * 8 + c) * 64 + lane]; ss += (O[rg][c][0] * O[rg][c][0] + O[rg][c][1] * O[rg][c][1]) + (O[rg][c][2] * O[rg][c][2] + O[rg][c][3] * O[rg][c][3]); }
                ss = xsum32(xsum16(ss));
                const float rn = post / sqrtf(ss * (1.0f / 128.0f) + EPS);
                bf16_t* orow = U + (size_t)(qrow0 + 32 * wq + 16 * rg + r) * LDU + U_DAQ + h * 128;
#pragma unroll
                for (int c = 0; c < 8; ++c) { const f32x4 gg = *(const f32x4*)(hg + h * 128 + 16 * c + 4 * qq); const f32x4 y = O[rg][c] * rn * gg;
                    u32x2 w; w.x = cvt_pk_bf16(y[0], y[1]); w.y = cvt_pk_bf16(y[2], y[3]); *(u32x2*)(orow + 16 * c + 4 * qq) = w; }
            }
        }
    }
}

__device__ __forceinline__ float logsigmoidf_(float x) { return fminf(x, 0.f) - __logf(1.0f + __expf(-fabsf(x))); }
__device__ __forceinline__ void gate_scan(const float* G, int row0, int icol, int fcol, int dir, float m, int lane, LAS float* tg, LAS float* tM, LAS float* tb, float& b_end, float& M_end) {
    const int p0 = dir ? 127 - 2 * lane : 2 * lane, p1 = dir ? p0 - 1 : p0 + 1;
    const float f0 = G[(size_t)(row0 + p0) * 16 + fcol], f1 = G[(size_t)(row0 + p1) * 16 + fcol];
    const float i0 = G[(size_t)(row0 + p0) * 16 + icol], i1 = G[(size_t)(row0 + p1) * 16 + icol];
    const float lf0 = logsigmoidf_(f0), lf1 = logsigmoidf_(f1);
    float inc = lf0 + lf1;
#pragma unroll
    for (int o = 1; o < 64; o <<= 1) { const float t = __shfl_up(inc, o); if (lane >= o) inc += t; }
    float exc = __shfl_up(inc, 1); if (lane == 0) exc = 0.f;
    const float b0 = exc + lf0, b1 = b0 + lf1;
    const float g0 = i0 - b0, g1 = i1 - b1;
    float cm = fmaxf(g0, g1);
#pragma unroll
    for (int o = 1; o < 64; o <<= 1) { const float t = __shfl_up(cm, o); if (lane >= o) cm = fmaxf(cm, t); }
    float exm = __shfl_up(cm, 1); if (lane == 0) exm = -1e30f;
    const float G0 = fmaxf(exm, g0), G1 = fmaxf(G0, g1);
    const float M0 = fmaxf(m, G0), M1 = fmaxf(m, G1);
    tg[p0] = g0; tg[p1] = g1; tM[p0] = M0; tM[p1] = M1; tb[p0] = b0; tb[p1] = b1;
    b_end = __shfl(b1, 63); M_end = __shfl(M1, 63);
}
__device__ __forceinline__ int chunk_row0(int b, int dir, int s) {
    if (s < 2) return ML_ROWS + b * CTXL + 128 * (dir ? 1 - s : s);
    return b * SEQ + 128 * (dir ? 33 - s : s - 2);
}
__device__ __forceinline__ void mlstm_state_unit(ldsp lds, const bf16_t* KT, const bf16_t* TT, const float* G, bf16_t* CT, float* NST, float* MST, int chain, int j) {
    int tid = threadIdx.x; asm volatile("" : "+v"(tid)); const int lane = tid & 63, wv = tid >> 6, r = lane & 15, qq = lane >> 4;
    const int dir = chain & 1, bh = chain >> 1, b = bh >> 2, h = bh & 3;
    const int dvq = j >> 1, dkh = j & 1, wa = wv >> 2, wb = wv & 3; const bool nown = (dvq == 0) && (wa == 0);
    const int dv0 = 64 * dvq + 32 * wa, dk0w = 128 * dkh + 32 * wb;
    LAS float* tgs = (LAS float*)lds; LAS float* tend = tgs + NCH * 128; LAS float* tdm = tend + 2 * NCH + 4;
    ldsp stg = (ldsp)(tdm + 8 * 256) + wv * (32 * 80);
    const int icol = (dir ? 8 : 0) + h, fcol = (dir ? 12 : 4) + h;
    __syncthreads();
    for (int s = wv; s < NCH; s += 8) { float be, Me; gate_scan(G, chunk_row0(b, dir, s), icol, fcol, dir, -1e30f, lane, tgs + s * 128, tdm + wv * 256, tdm + wv * 256 + 128, be, Me);
        if (lane == 0) { tend[2 * s] = Me; tend[2 * s + 1] = be; } }
    __syncthreads();
    f32x4 acc[2][2];
#pragma unroll
    for (int a = 0; a < 2; ++a)
#pragma unroll
        for (int e = 0; e < 2; ++e) acc[a][e] = (f32x4){0.f, 0.f, 0.f, 0.f};
    float nval[2] = {0.f, 0.f}, m = 0.f;
    bf16x8 k0[2][2], v0[2][2], k1[2][2], v1[2][2], k2[2][2], v2[2][2], k3[2][2], v3[2][2];
    const bf16_t* kbase = KT + (size_t)(h * 256 + dk0w + r) * LDT + 8 * qq;
    const bf16_t* vbase = TT + (size_t)(h * 256 + dv0 + r) * LDT + 8 * qq;
#define M1_LOAD(KR, VR, s_, hf) do { const int row0_ = chunk_row0(b, dir, (s_)) + 64 * (hf); \
        _Pragma("unroll") for (int e = 0; e < 2; ++e) _Pragma("unroll") for (int ks = 0; ks < 2; ++ks) { \
            KR[e][ks] = *(const bf16x8*)(kbase + (size_t)(16 * e) * LDT + row0_ + 32 * ks); VR[e][ks] = *(const bf16x8*)(vbase + (size_t)(16 * e) * LDT + row0_ + 32 * ks); } } while (0)
    float Mend_ = 0.f, decay_ = 1.f, bend_ = 0.f, ns0_ = 0.f, ns1_ = 0.f;
#define M1_BEGIN(s_) do { \
        { _Pragma("unroll") for (int a = 0; a < 2; ++a) _Pragma("unroll") for (int e = 0; e < 2; ++e) _Pragma("unroll") for (int jj = 0; jj < 4; ++jj) \
              *(LAS bf16_t*)(stg + (16 * a + 4 * qq + jj) * 80 + (16 * e + r) * 2) = (bf16_t)(cvt_pk_bf16(acc[a][e][jj], 0.f) & 0xffffu); \
          if (nown) { if (qq == 0) { NST[(size_t)(chain * NCH + (s_)) * 256 + dk0w + r] = nval[0]; NST[(size_t)(chain * NCH + (s_)) * 256 + dk0w + 16 + r] = nval[1]; } if (j == 0 && tid == 0) MST[chain * NCH + (s_)] = m; } \
          asm volatile("s_waitcnt lgkmcnt(0)" ::: "memory"); \
          bf16_t* ct = CT + ((size_t)(chain * NCH + (s_))) * 65536 + (size_t)dv0 * 256 + dk0w; \
          _Pragma("unroll") for (int i = 0; i < 2; ++i) { const int pc_ = lane + 64 * i, row_ = pc_ >> 2, cv_ = pc_ & 3; \
              *(u32x4*)(ct + (size_t)row_ * 256 + cv_ * 8) = *(const LAS u32x4*)(stg + row_ * 80 + cv_ * 16); } } \
        const float Gend_ = tend[2 * (s_)]; bend_ = tend[2 * (s_) + 1]; Mend_ = fmaxf(m, Gend_); decay_ = __expf(m - Mend_); \
        _Pragma("unroll") for (int a = 0; a < 2; ++a) _Pragma("unroll") for (int e = 0; e < 2; ++e) acc[a][e] = acc[a][e] * decay_; \
        ns0_ = 0.f; ns1_ = 0.f; } while (0)
#define M1_HALF(KR, VR, s_, hf) do { \
        _Pragma("unroll") for (int ks = 0; ks < 2; ++ks) { \
            const f32x4 g0_ = *(const LAS f32x4*)(tgs + (s_) * 128 + 64 * (hf) + 32 * ks + 8 * qq), g1_ = *(const LAS f32x4*)(tgs + (s_) * 128 + 64 * (hf) + 32 * ks + 8 * qq + 4); \
            float w_[8]; _Pragma("unroll") for (int i = 0; i < 4; ++i) { w_[i] = __expf(g0_[i] - Mend_); w_[4 + i] = __expf(g1_[i] - Mend_); } \
            bf16x8 vw_[2]; \
            _Pragma("unroll") for (int a = 0; a < 2; ++a) { const u32x4 x_ = __builtin_bit_cast(u32x4, VR[a][ks]); const unsigned xs_[4] = {x_.x, x_.y, x_.z, x_.w}; u32x4 o_; unsigned os_[4]; \
                _Pragma("unroll") for (int i = 0; i < 4; ++i) os_[i] = cvt_pk_bf16(__uint_as_float(xs_[i] << 16) * w_[2 * i], __uint_as_float(xs_[i] & 0xffff0000u) * w_[2 * i + 1]); \
                o_.x = os_[0]; o_.y = os_[1]; o_.z = os_[2]; o_.w = os_[3]; vw_[a] = __builtin_bit_cast(bf16x8, o_); } \
            if (nown) { _Pragma("unroll") for (int e = 0; e < 2; ++e) { const u32x4 x_ = __builtin_bit_cast(u32x4, KR[e][ks]); const unsigned xs_[4] = {x_.x, x_.y, x_.z, x_.w}; float t_ = 0.f; \
                _Pragma("unroll") for (int i = 0; i < 4; ++i) t_ += __uint_as_float(xs_[i] << 16) * w_[2 * i] + __uint_as_float(xs_[i] & 0xffff0000u) * w_[2 * i + 1]; \
                if (e == 0) ns0_ += t_; else ns1_ += t_; } } \
            _Pragma("unroll") for (int e = 0; e < 2; ++e) _Pragma("unroll") for (int a = 0; a < 2; ++a) acc[a][e] = mfma16(vw_[a], KR[e][ks], acc[a][e]); } } while (0)
#define M1_END() do { \
        if (nown) { nval[0] = decay_ * nval[0] + xsum32(xsum16(ns0_)); nval[1] = decay_ * nval[1] + xsum32(xsum16(ns1_)); } \
        m = bend_ + Mend_; } while (0)
    M1_LOAD(k0, v0, 0, 0); M1_LOAD(k1, v1, 0, 1); M1_LOAD(k2, v2, 1, 0); M1_LOAD(k3, v3, 1, 1);
#pragma unroll 1
    for (int s = 0; s < NCH; s += 2) {
        M1_BEGIN(s);
        M1_HALF(k0, v0, s, 0); if (s + 2 < NCH) M1_LOAD(k0, v0, s + 2, 0);
        M1_HALF(k1, v1, s, 1); if (s + 2 < NCH) M1_LOAD(k1, v1, s + 2, 1);
        M1_END();
        M1_BEGIN(s + 1);
        M1_HALF(k2, v2, s + 1, 0); if (s + 3 < NCH) M1_LOAD(k2, v2, s + 3, 0);
        M1_HALF(k3, v3, s + 1, 1); if (s + 3 < NCH) M1_LOAD(k3, v3, s + 3, 1);
        M1_END();
    }
#undef M1_BEGIN
#undef M1_HALF
#undef M1_END
#undef M1_LOAD
}
__device__ __forceinline__ void mlstm_out_unit(ldsp lds, bf16_t* U, const bf16_t* TT, const float* G, const bf16_t* CT, const float* NST, const float* MST, const float* hg, int b, int h, int loc) {
    int tid = threadIdx.x; asm volatile("" : "+v"(tid)); const int lane = tid & 63, wv = tid >> 6, r = lane & 15, qq = lane >> 4;
    constexpr int QP = 544, PP = 288, QS = 0, KS = 128 * QP, TB = 2 * 128 * QP;
    LAS float* tgF = (LAS float*)(lds + TB); LAS float* tMF = tgF + 128; LAS float* tbF = tgF + 256;
    LAS float* tgB = tgF + 384; LAS float* tMB = tgF + 512; LAS float* tbB = tgF + 640;
    LAS float* tcf = tgF + 768; LAS float* tcb = tgF + 896; LAS float* tss = tgF + 1024;
    const int row0 = loc < 2 ? ML_ROWS + b * CTXL + 128 * loc : b * SEQ + 128 * (loc - 2);
    const int sF = loc, sB = loc < 2 ? 1 - loc : 35 - loc;
    const int chF = ((b * 4 + h) * 2), chB = chF + 1;
    const float mF = MST[chF * NCH + sF], mB = MST[chB * NCH + sB];
    __syncthreads();
#pragma unroll
    for (int i = 0; i < 8; ++i) { const int v = tid + 512 * i, row = v >> 5, cv = v & 31;
        *(LAS u32x4*)(lds + QS + row * QP + cv * 16) = *(const u32x4*)(U + (size_t)(row0 + row) * LDU + U_MLQ + h * 256 + cv * 8);
        *(LAS u32x4*)(lds + KS + row * QP + cv * 16) = *(const u32x4*)(U + (size_t)(row0 + row) * LDU + U_MLK + h * 256 + cv * 8); }
    LAS bf16_t* tn = (LAS bf16_t*)(tss + 1024);
    if (wv == 2) { const int d = lane >> 5, pc = lane & 31; const float* np = NST + (size_t)(d ? chB * NCH + sB : chF * NCH + sF) * 256 + 8 * pc;
        *(LAS u32x4*)(tn + d * 256 + 8 * pc) = pack8(*(const f32x4*)np, *(const f32x4*)(np + 4)); }
    if (wv == 0) { float be, Me; gate_scan(G, row0, h, 4 + h, 0, mF, lane, tgF, tMF, tbF, be, Me); }
    if (wv == 1) { float be, Me; gate_scan(G, row0, 8 + h, 12 + h, 1, mB, lane, tgB, tMB, tbB, be, Me); }
    __syncthreads();
    {
        const int p = 16 * wv + r;
        f32x4 S[8], Sn = (f32x4){0.f, 0.f, 0.f, 0.f};
#pragma unroll
        for (int ct = 0; ct < 8; ++ct) S[ct] = (f32x4){0.f, 0.f, 0.f, 0.f};
#pragma unroll 2
        for (int ks = 0; ks < 8; ++ks) {
            const bf16x8 qv = *(const LAS bf16x8*)(lds + QS + p * QP + (32 * ks + 8 * qq) * 2);
#pragma unroll
            for (int ct = 0; ct < 8; ++ct) S[ct] = mfma16(*(const LAS bf16x8*)(lds + KS + (16 * ct + r) * QP + (32 * ks + 8 * qq) * 2), qv, S[ct]);
            u32x4 w = *(const LAS u32x4*)(tn + (r & 1) * 256 + 32 * ks + 8 * qq);
            if (r >= 2) w = (u32x4){0u, 0u, 0u, 0u};
            Sn = mfma16(__builtin_bit_cast(bf16x8, w), qv, Sn);
        }
        const float qnF = __shfl(Sn[0], r), qnB = __shfl(Sn[1], r);
        const float MFp = tMF[p], MBp = tMB[p];
        float sumF = 0.f, sumB = 0.f;
#pragma unroll
        for (int ct = 0; ct < 8; ++ct)
#pragma unroll
            for (int jj = 0; jj < 4; ++jj) { const int sg = 16 * ct + 4 * qq + jj;
                const float ef = sg <= p ? __expf(tgF[sg] - MFp) : 0.f, eb = sg >= p ? __expf(tgB[sg] - MBp) : 0.f;
                sumF += ef * S[ct][jj]; sumB += eb * S[ct][jj]; }
        sumF += __shfl_xor(sumF, 16); sumF += __shfl_xor(sumF, 32); sumB += __shfl_xor(sumB, 16); sumB += __shfl_xor(sumB, 32);
        const float scF = __expf(mF - MFp), scB = __expf(mB - MBp);
        const float denF = scF * qnF + sumF, denB = scB * qnB + sumB;
        const float rF = 1.0f / fmaxf(fabsf(denF), __expf(-(tbF[p] + MFp))), rB = 1.0f / fmaxf(fabsf(denB), __expf(-(tbB[p] + MBp)));
        if (qq == 0) { tcf[p] = scF * rF; tcb[p] = scB * rB; }
#pragma unroll
        for (int ct = 0; ct < 8; ++ct)
#pragma unroll
            for (int jj = 0; jj < 4; ++jj) { const int sg = 16 * ct + 4 * qq + jj;
                const float ef = sg <= p ? __expf(tgF[sg] - MFp) : 0.f, eb = sg >= p ? __expf(tgB[sg] - MBp) : 0.f;
                S[ct][jj] *= (ef * rF + eb * rB); }
        __syncthreads();
#pragma unroll
        for (int ct = 0; ct < 8; ++ct) {
            u32x2 w; w.x = cvt_pk_bf16(S[ct][0], S[ct][1]); w.y = cvt_pk_bf16(S[ct][2], S[ct][3]);
            *(LAS u32x2*)(lds + KS + p * PP + (16 * ct + 4 * qq) * 2) = w; }
    }
    __syncthreads();
    f32x4 O[2][8];
#pragma unroll
    for (int a = 0; a < 2; ++a)
#pragma unroll
        for (int tt = 0; tt < 8; ++tt) O[a][tt] = (f32x4){0.f, 0.f, 0.f, 0.f};
    bf16x8 cfA[8], cfB[8];
#define M2_CF(CF, pass_) do { const bf16_t* ct_ = CT + (size_t)(((pass_) & 1) ? chB * NCH + sB : chF * NCH + sF) * 65536 + (size_t)(32 * wv + 16 * ((pass_) >> 1) + r) * 256 + 8 * qq; \
        _Pragma("unroll") for (int ks = 0; ks < 8; ++ks) CF[ks] = *(const bf16x8*)(ct_ + 32 * ks); } while (0)
#define M2_PASS(CF, pass_) do { f32x4 T[8]; \
        _Pragma("unroll") for (int tt = 0; tt < 8; ++tt) T[tt] = (f32x4){0.f, 0.f, 0.f, 0.f}; \
        _Pragma("unroll") for (int ks = 0; ks < 8; ++ks) { \
            _Pragma("unroll") for (int tt = 0; tt < 8; ++tt) T[tt] = mfma16(CF[ks], *(const LAS bf16x8*)(lds + QS + (16 * tt + r) * QP + (32 * ks + 8 * qq) * 2), T[tt]); \
            SCHED_FENCE(); } \
        LAS float* tc_ = ((pass_) & 1) ? tcb : tcf; \
        _Pragma("unroll") for (int tt = 0; tt < 8; ++tt) O[(pass_) >> 1][tt] = O[(pass_) >> 1][tt] + T[tt] * tc_[16 * tt + r]; } while (0)
    bf16x8 vf[2][4];
    M2_CF(cfA, 0);
    M2_CF(cfB, 1); M2_PASS(cfA, 0);
    M2_CF(cfA, 2); M2_PASS(cfB, 1);
    M2_CF(cfB, 3); M2_PASS(cfA, 2);
#pragma unroll
    for (int a = 0; a < 2; ++a)
#pragma unroll
        for (int u = 0; u < 4; ++u) vf[a][u] = *(const bf16x8*)(TT + (size_t)(h * 256 + 32 * wv + 16 * a + r) * LDT + row0 + 32 * u + 8 * qq);
    M2_PASS(cfB, 3);
#undef M2_CF
#undef M2_PASS
    {
#pragma unroll
        for (int u = 0; u < 4; ++u) {
#pragma unroll
            for (int tt = 0; tt < 8; ++tt) { const bf16x8 pv = *(const LAS bf16x8*)(lds + KS + (16 * tt + r) * PP + (32 * u + 8 * qq) * 2);
                O[0][tt] = mfma16(vf[0][u], pv, O[0][tt]); O[1][tt] = mfma16(vf[1][u], pv, O[1][tt]); }
            SCHED_FENCE();
        }
    }
#pragma unroll
    for (int tt = 0; tt < 8; ++tt) { float ss = 0.f;
#pragma unroll
        for (int a = 0; a < 2; ++a) ss += (O[a][tt][0] * O[a][tt][0] + O[a][tt][1] * O[a][tt][1]) + (O[a][tt][2] * O[a][tt][2] + O[a][tt][3] * O[a][tt][3]);
        ss += __shfl_xor(ss, 16); ss += __shfl_xor(ss, 32);
        if (qq == 0) tss[wv * 128 + 16 * tt + r] = ss; }
    __syncthreads();
#pragma unroll
    for (int tt = 0; tt < 8; ++tt) { const int p = 16 * tt + r; float ss = 0.f;
#pragma unroll
        for (int w = 0; w < 8; ++w) ss += tss[w * 128 + p];
        const float rn = 1.0f / sqrtf(ss * (1.0f / 256.0f) + EPS);
#pragma unroll
        for (int a = 0; a < 2; ++a) { const int dv = 32 * wv + 16 * a + 4 * qq;
            bf16_t* op = U + (size_t)(row0 + p) * LDU + U_OG + h * 256 + dv;
            const u32x2 gw = *(const u32x2*)op; const f32x4 gg = *(const f32x4*)(hg + h * 256 + dv);
            f32x4 y = O[a][tt] * rn * gg;
            y[0] *= __uint_as_float(gw.x << 16); y[1] *= __uint_as_float(gw.x & 0xffff0000u); y[2] *= __uint_as_float(gw.y << 16); y[3] *= __uint_as_float(gw.y & 0xffff0000u);
            u32x2 w; w.x = cvt_pk_bf16(y[0], y[1]); w.y = cvt_pk_bf16(y[2], y[3]); *(u32x2*)op = w; }
    }
}


#define XB_TMO      128
#define XB_XCNT(j)  (256  + 64 * (j))
#define XB_XSUB(j)  (1280 + 64 * (j))
#define XB_XGEN(j)  (2304 + 64 * (j))
#define XB_TOP      3328
#define XB_TOPGEN   3392
#define XCD_BAR_WORDS 3456
#define XB_SPIN_CAP (1u << 18)
__device__ __forceinline__ unsigned xb_ld(unsigned* p)              { return __hip_atomic_load(p, __ATOMIC_RELAXED, __HIP_MEMORY_SCOPE_AGENT); }
__device__ __forceinline__ unsigned xb_add(unsigned* p, unsigned v) { return __hip_atomic_fetch_add(p, v, __ATOMIC_RELAXED, __HIP_MEMORY_SCOPE_AGENT); }
__device__ __forceinline__ unsigned xb_xcc_id() { return (unsigned)__builtin_amdgcn_s_getreg((3 << 11) | 20) & 0xFu; }
#define XB_SPIN(cond, bar) do { unsigned _sp = 0; while (cond) { __builtin_amdgcn_s_sleep(1); \
    if ((++_sp & 255u) == 0u) { if (xb_ld(&(bar)[XB_TMO])) break; if (_sp > XB_SPIN_CAP) { atomicAdd(&(bar)[XB_TMO], 1u); break; } } } } while (0)
struct XcdBarrier { unsigned* bar; unsigned x; volatile LAS unsigned* st; };
__device__ __forceinline__ XcdBarrier xcd_barrier_post(unsigned* bar, volatile LAS unsigned* st) {
    XcdBarrier b; b.bar = bar; b.x = xb_xcc_id(); b.st = st;
    if (threadIdx.x == 0) (void)xb_add(&bar[XB_XCNT(b.x)], 1u);
    return b;
}
__device__ __forceinline__ void xcd_barrier_complete(unsigned* bar, unsigned x, unsigned& nloc, unsigned& nx) {
    const unsigned G = gridDim.x * gridDim.y * gridDim.z;
    unsigned sum, cnt, mine, sp = 0u;
    for (;;) {
        sum = 0u; cnt = 0u; mine = 0u;
#pragma unroll
        for (unsigned j = 0; j < 16; ++j) { const unsigned c = xb_ld(&bar[XB_XCNT(j)]); sum += c; cnt += (c > 0u) ? 1u : 0u; mine = (j == x) ? c : mine; }
        if (sum == G) break;
        __builtin_amdgcn_s_sleep(1);
        if ((++sp & 255u) == 0u) { if (xb_ld(&bar[XB_TMO])) break; if (sp > XB_SPIN_CAP) { atomicAdd(&bar[XB_TMO], 1u); break; } }
    }
    nloc = mine > 0u ? mine : 1u; nx = cnt > 0u ? cnt : 1u;
}
__device__ __forceinline__ void xcd_barrier(const XcdBarrier& b) {
    asm volatile("s_waitcnt vmcnt(0)" ::: "memory");
    __syncthreads();
    if (threadIdx.x == 0) {
        unsigned* bar = b.bar;
        __builtin_amdgcn_s_waitcnt(0);
        unsigned nloc = b.st[0], nx = b.st[1];
        if (nloc == 0u) { xcd_barrier_complete(bar, b.x, nloc, nx); b.st[0] = nloc; b.st[1] = nx; }
        const unsigned old = xb_add(&bar[XB_XSUB(b.x)], 1u);
        const unsigned gen = old / nloc;
        if (old + 1u == (gen + 1u) * nloc) {
            __builtin_amdgcn_fence(__ATOMIC_RELEASE, "agent");
            asm volatile("s_waitcnt vmcnt(0)" ::: "memory");
            const unsigned og = xb_add(&bar[XB_TOP], 1u);
            const unsigned tg = og / nx;
            if (og + 1u == (tg + 1u) * nx) xb_add(&bar[XB_TOPGEN], 1u);
            else XB_SPIN(xb_ld(&bar[XB_TOPGEN]) == tg, bar);
            __builtin_amdgcn_fence(__ATOMIC_ACQUIRE, "agent");
            xb_add(&bar[XB_XGEN(b.x)], 1u);
            asm volatile("s_waitcnt vmcnt(0)" ::: "memory");
        } else {
            XB_SPIN(xb_ld(&bar[XB_XGEN(b.x)]) == gen, bar);
            __builtin_amdgcn_fence(__ATOMIC_ACQUIRE, "agent");
            asm volatile("s_waitcnt vmcnt(0)" ::: "memory");
        }
    }
    __syncthreads();
}

struct Params {
    const float *x, *c, *ctx, *c_ctx, *w_ada, *b_ada, *norm_g, *w_in, *ml_gate_b, *ml_head_g, *da_lam, *da_head_g, *w_br_ml, *w_br_da, *w_br_fn, *w_out, *w_ffn_in, *w_ffn_out, *final_g;
    float* out; unsigned char* ws;
};

struct WSeg { const float* W; int ldn, off, width, K; bf16_t* dst; int Kd, row_off, perm, nitems; };
__device__ __forceinline__ WSeg wseg(const Params& P, int l, int s) {
    WSeg g; unsigned char* ws = P.ws;
    const float* win = P.w_in + (size_t)l * DM * DIN; bf16_t* WIN = (bf16_t*)(ws + WS_WIN);
    g.ldn = DIN; g.K = DM; g.Kd = DM; g.perm = 0; g.width = 1024; g.W = win; g.dst = WIN; g.off = 0; g.row_off = 0;
    switch (s) {
        case 0: g.off = 0;    g.row_off = 7424; break;
        case 1: g.off = 1024; g.row_off = 8448; break;
        case 2: g.off = 2048; g.row_off = 9472; break;
        case 3: g.off = 3072; g.row_off = 6400; break;
        case 4: g.off = 4096; g.row_off = 0; g.width = 16; break;
        case 5: g.off = 4112; g.row_off = 5376; g.perm = 1; break;
        case 6: g.off = 5136; g.row_off = 4352; g.perm = 1; break;
        case 7: g.off = 6160; g.row_off = 10496; break;
        case 8: g.off = 7184; g.row_off = 3328; break;
        case 9: g.off = 8208; g.row_off = 256; g.width = 3072; break;
        case 10: g.W = P.w_br_ml + (size_t)l * DM * DM; g.ldn = DM; g.dst = (bf16_t*)(ws + WS_WBR); break;
        case 11: g.W = P.w_br_da + (size_t)l * DM * DM; g.ldn = DM; g.dst = (bf16_t*)(ws + WS_WBR) + (size_t)DM * DM; break;
        case 12: g.W = P.w_br_fn + (size_t)l * DM * DM; g.ldn = DM; g.dst = (bf16_t*)(ws + WS_WBR) + (size_t)2 * DM * DM; break;
        case 13: g.W = P.w_out + (size_t)l * DM * DM; g.ldn = DM; g.dst = (bf16_t*)(ws + WS_WOUT); break;
        case 14: g.W = P.w_ffn_in + (size_t)l * DM * 2 * DFF; g.ldn = 2 * DFF; g.width = 2 * DFF; g.dst = (bf16_t*)(ws + WS_WF1); g.perm = 2; break;
        default: g.W = P.w_ffn_out + (size_t)l * DFF * DM; g.ldn = DM; g.K = DFF; g.Kd = DFF; g.dst = (bf16_t*)(ws + WS_WF2); break;
    }
    g.nitems = (g.K / 64) * ((g.width + 31) / 32);
    return g;
}


__device__ __forceinline__ void convert_dynamic(const Params& P, ldsp lds, int lw, int s_lo, int s_hi, unsigned* ctr, int max_grabs = 1 << 30) {
    int tid = threadIdx.x; asm volatile("" : "+v"(tid)); const int lane = tid & 63, wv = tid >> 6;
    LAS float* scr = (LAS float*)(lds + wv * 8448); LAS unsigned* slot = (LAS unsigned*)(lds + 8 * 8448);
    int total = 0;
    for (int sg = s_lo; sg < s_hi; ++sg) total += wseg(P, lw, sg).nitems;
    __syncthreads();
    for (int gcount = 0; gcount < max_grabs; ++gcount) {
        if (tid == 0) *slot = atomicAdd(ctr, 8u);
        __syncthreads();
        const int base = (int)*slot;
        __syncthreads();
        if (base >= total) break;
        int it = base + wv;
        if (it < total) {
            int sg = s_lo; WSeg g = wseg(P, lw, sg);
            while (it >= g.nitems) { it -= g.nitems; ++sg; g = wseg(P, lw, sg); }
            const int nbk = (g.width + 31) / 32;
            transpose_item(g.W, g.ldn, g.off, g.width, g.dst, g.Kd, g.row_off, g.perm, scr, it / nbk, it % nbk, lane);
        }
    }
}

__global__ void __launch_bounds__(512, 2) fwd_megakernel(Params P) {
    extern __shared__ __attribute__((aligned(16))) unsigned char lds_raw[];
    cg::grid_group grid = cg::this_grid();
    ldsp lds = (ldsp)lds_raw;
    int tid = threadIdx.x; asm volatile("" : "+v"(tid)); const int G = gridDim.x, bx = blockIdx.x;
    const int vcu = (G % 8 == 0) ? (bx % 8) * (G / 8) + bx / 8 : bx;
    const int NGW = G * 8;
    const int gt = bx * 512 + tid, NGT = G * 512;
    volatile LAS unsigned* xst = (volatile LAS unsigned*)(lds + LDS_BYTES - 16);
    if (threadIdx.x < 4) xst[threadIdx.x] = 0u;
    __syncthreads();
    const XcdBarrier xbar = xcd_barrier_post((unsigned*)(P.ws + WS_BAR), xst);
    {
    unsigned char* ws = P.ws; asm volatile("" : "+s"(ws));
    bf16_t* U = (bf16_t*)(ws + WS_U); bf16_t* TT = (bf16_t*)(ws + WS_TT); float* XC = (float*)(ws + WS_XC); bf16_t* AB = (bf16_t*)(ws + WS_AB);
    bf16_t* AT = (bf16_t*)(ws + WS_AB); bf16_t* KT = (bf16_t*)(ws + WS_KT); bf16_t* ATC = (bf16_t*)(ws + WS_ATC); bf16_t* Dm = (bf16_t*)(ws + WS_D); bf16_t* Dc = (bf16_t*)(ws + WS_DC); bf16_t* Wc = (bf16_t*)(ws + WS_WC);
    float* ROPE = (float*)(ws + WS_ROPE); float* MODS = (float*)(ws + WS_MODS); float* GG = (float*)(ws + WS_G); float* NST = (float*)(ws + WS_NST); float* MST = (float*)(ws + WS_MST);
    unsigned* CTR = (unsigned*)(ws + WS_CTR); bf16_t* CT = (bf16_t*)(ws + WS_CT); float* Y = (float*)(ws + WS_CT); float* YC = (float*)(ws + WS_CT + 72 * MiB); float* TP6 = (float*)(ws + WS_CT); float* TP9 = (float*)(ws + WS_CT + 4 * MiB); bf16_t* HID = (bf16_t*)(ws + WS_U);
    bf16_t* WIN = (bf16_t*)(ws + WS_WIN); bf16_t* WBR = (bf16_t*)(ws + WS_WBR); bf16_t* WOUT = (bf16_t*)(ws + WS_WOUT); bf16_t* WF1 = (bf16_t*)(ws + WS_WF1); bf16_t* WF2 = (bf16_t*)(ws + WS_WF2);

        for (int v = gt; v < 4096 * 512; v += NGT) { const int tp = v >> 9, k0 = (v & 511) * 8; float e[8];
#pragma unroll
            for (int j = 0; j < 8; ++j) { const int k = k0 + j; const float a = (float)((k * tp) & 4095) * (1.0f / 2048.0f); e[j] = (k <= 2048 ? cospif(a) : -sinpif(a)) * (1.0f / 64.0f); }
            u32x4 w; w.x = cvt_pk_bf16(e[0], e[1]); w.y = cvt_pk_bf16(e[2], e[3]); w.z = cvt_pk_bf16(e[4], e[5]); w.w = cvt_pk_bf16(e[6], e[7]);
            *(u32x4*)(Dm + (size_t)tp * 4096 + k0) = w; }
        for (int v = gt; v < 256 * 512; v += NGT) {
            { const int tp = v >> 9, k = v & 511, ri = k >> 8, t = k & 255; const float a = (float)((t * tp) & 255) * (1.0f / 128.0f);
              Dc[v] = (bf16_t)(cvt_pk_bf16((ri ? sinpif(a) : cospif(a)) * (1.0f / 16.0f), 0.f) & 0xffffu); }
            { const int row = v >> 8, c = v & 255, ri = row >> 8, cp = row & 255; const float a = (float)((c * cp) & 255) * (1.0f / 128.0f);
              Wc[v] = (bf16_t)(cvt_pk_bf16((ri ? -sinpif(a) : cospif(a)) * (1.0f / 16.0f), 0.f) & 0xffffu); }
        }
        for (int v = gt; v < 4096 * 32; v += NGT) { const int t = v >> 5, i = v & 31; const float pos = (float)(i < 16 ? (t >> 6) : (t & 63));
            const float inv = powf(10000.0f, -(float)(i & 15) * (1.0f / 16.0f)); const float ang = pos * inv; ROPE[2 * v] = cosf(ang); ROPE[2 * v + 1] = sinf(ang); }
        LAS float* sl = (LAS float*)lds; LAS float* red = sl + 5 * 1024;
        for (int i = tid; i < 5 * 1024; i += 512) { const float cvv = i < 4096 ? P.c[i] : P.c_ctx[i - 4096]; sl[i] = cvv * sigmoidf_(cvv); }
        __syncthreads();
        for (int it = bx; it < DEPTH * 192; it += G) {
            const int l = it / 192, n0 = (it % 192) * 32, col = tid & 31, ksg = tid >> 5;
            const float* W = P.w_ada + (size_t)l * DM * 6144 + n0 + col;
            float a[5] = {0.f, 0.f, 0.f, 0.f, 0.f};
#pragma unroll 8
            for (int kk = 0; kk < 64; ++kk) { const int k = ksg * 64 + kk; const float w = W[(size_t)k * 6144];
#pragma unroll
                for (int s = 0; s < 5; ++s) a[s] += sl[s * 1024 + k] * w; }
#pragma unroll
            for (int s = 0; s < 5; ++s) red[(ksg * 5 + s) * 32 + col] = a[s];
            __syncthreads();
            if (tid < 160) { const int s = tid >> 5, cc = tid & 31; float sum = 0.f;
#pragma unroll
                for (int q = 0; q < 16; ++q) sum += red[(q * 5 + s) * 32 + cc];
                MODS[(size_t)(l * 5 + s) * 6144 + n0 + cc] = sum + P.b_ada[(size_t)l * 6144 + n0 + cc]; }
            __syncthreads();
        }
    }
    grid.sync();

#pragma unroll 1
    for (int l = 0; l < DEPTH; ++l) {
        int tidl = threadIdx.x; asm volatile("" : "+v"(tidl));
        const int lane = tidl & 63, wv = tidl >> 6, gw = bx * 8 + wv;
    unsigned char* ws = P.ws; asm volatile("" : "+s"(ws));
    bf16_t* U = (bf16_t*)(ws + WS_U); bf16_t* TT = (bf16_t*)(ws + WS_TT); float* XC = (float*)(ws + WS_XC); bf16_t* AB = (bf16_t*)(ws + WS_AB);
    bf16_t* AT = (bf16_t*)(ws + WS_AB); bf16_t* KT = (bf16_t*)(ws + WS_KT); bf16_t* ATC = (bf16_t*)(ws + WS_ATC); bf16_t* Dm = (bf16_t*)(ws + WS_D); bf16_t* Dc = (bf16_t*)(ws + WS_DC); bf16_t* Wc = (bf16_t*)(ws + WS_WC);
    float* ROPE = (float*)(ws + WS_ROPE); float* MODS = (float*)(ws + WS_MODS); float* GG = (float*)(ws + WS_G); float* NST = (float*)(ws + WS_NST); float* MST = (float*)(ws + WS_MST);
    unsigned* CTR = (unsigned*)(ws + WS_CTR); bf16_t* CT = (bf16_t*)(ws + WS_CT); float* Y = (float*)(ws + WS_CT); float* YC = (float*)(ws + WS_CT + 72 * MiB); float* TP6 = (float*)(ws + WS_CT); float* TP9 = (float*)(ws + WS_CT + 4 * MiB); bf16_t* HID = (bf16_t*)(ws + WS_U);
    bf16_t* WIN = (bf16_t*)(ws + WS_WIN); bf16_t* WBR = (bf16_t*)(ws + WS_WBR); bf16_t* WOUT = (bf16_t*)(ws + WS_WOUT); bf16_t* WF1 = (bf16_t*)(ws + WS_WF1); bf16_t* WF2 = (bf16_t*)(ws + WS_WF2);

        const bool need_ctx = l < DEPTH - 1;
        const float lam_init = 0.8f - 0.6f * expf(-0.3f * (float)l);
        const float* srcL = l == 0 ? P.x : P.out; const float* srcC = l == 0 ? P.ctx : XC;
        const float* mods = MODS + (size_t)l * 5 * 6144;
        const int nMr = need_ctx ? 68 : 64;
        {
            LAS float* scr = (LAS float*)(lds + wv * 8448);
            int base = 0;
            for (int s = (l == 0 ? 0 : 15); s < 16; ++s) { const WSeg g = wseg(P, l, s); const int nbk = (g.width + 31) / 32;
                int it = gw - (base % NGW); if (it < 0) it += NGW;
                for (; it < g.nitems; it += NGW) transpose_item(g.W, g.ldn, g.off, g.width, g.dst, g.Kd, g.row_off, g.perm, scr, it / nbk, it % nbk, lane);
                base += g.nitems; }
            for (int row = gw; row < MROWS; row += NGW) { const bool lat = row < ML_ROWS; const int s = lat ? row >> 12 : 4;
                const float* xr = lat ? srcL + (size_t)row * DM : srcC + (size_t)(row - ML_ROWS) * DM;
                if (lat || l == 0) norm_mod_row(xr, P.norm_g + (size_t)(l * 2) * DM, mods + s * 6144, mods + s * 6144 + 1024, AB + (size_t)row * DM, lane);
                else norm_mod_row(xr, P.norm_g + (size_t)(l * 2) * DM, mods + s * 6144, mods + s * 6144 + 1024, AB + (size_t)row * DM, lane, TP9 + (size_t)(row - ML_ROWS) * DM, XC + (size_t)(row - ML_ROWS) * DM);
                if (l == 0 && !lat) {
#pragma unroll
                    for (int j = 0; j < 4; ++j) *(f32x4*)(XC + (size_t)(row - ML_ROWS) * DM + 4 * lane + 256 * j) = *(const f32x4*)(xr + 4 * lane + 256 * j); } }
        }
        xcd_barrier(xbar);
        {
            pg8::Sched S; S.init(AB, WIN, DM, DM, 68, 37, 1, 1, 0, 0, 0, 0, G, bx, true);
            EpiInproj E{U, GG, P.ml_gate_b + l * 16, ROPE};
            pg8::gemm_phase(lds, pg8::Gemm{DM, DM, DM}, S, E);
            pg8::Sched S2; S2.init(WIN + (size_t)8448 * DM, AB, DM, DM, 12, 68, 1, 1, 0, 0, 0, 0, G, bx, true);
            EpiTT E2{TT, KT};
            pg8::gemm_phase(lds, pg8::Gemm{DM, DM, DM}, S2, E2);
        }
        xcd_barrier(xbar);
        {
            {
                int tf = threadIdx.x; asm volatile("" : "+v"(tf)); const int lf = tf & 63, gwf = bx * 8 + (tf >> 6);
                for (int pr = gwf; pr < NB * 2047; pr += NGW) { const int b = pr / 2047, t = pr - b * 2047 + 1;
                    bf16_t* ra = U + (size_t)(b * SEQ + t) * LDU + U_FN + lf * 16; bf16_t* rb = U + (size_t)(b * SEQ + SEQ - t) * LDU + U_FN + lf * 16;
#pragma unroll
                    for (int i = 0; i < 2; ++i) { const u32x4 xa = *(const u32x4*)(ra + 8 * i), xb = *(const u32x4*)(rb + 8 * i);
                        const unsigned a4[4] = {xa.x, xa.y, xa.z, xa.w}, b4[4] = {xb.x, xb.y, xb.z, xb.w}; unsigned p4[4], m4[4];
#pragma unroll
                        for (int e = 0; e < 4; ++e) { const float al = __uint_as_float(a4[e] << 16), ah = __uint_as_float(a4[e] & 0xffff0000u), bl = __uint_as_float(b4[e] << 16), bh = __uint_as_float(b4[e] & 0xffff0000u);
                            p4[e] = cvt_pk_bf16(al + bl, ah + bh); m4[e] = cvt_pk_bf16(al - bl, ah - bh); }
                        *(u32x4*)(ra + 8 * i) = (u32x4){p4[0], p4[1], p4[2], p4[3]}; *(u32x4*)(rb + 8 * i) = (u32x4){m4[0], m4[1], m4[2], m4[3]}; } }
            }
            for (int u = vcu; u < 256; u += G) mlstm_state_unit(lds, KT, TT, GG, CT, NST, MST, u >> 3, u & 7);
            float lam;
            { const float* lq = P.da_lam + (size_t)l * 256; float s1 = 0.f, s2 = 0.f;
              for (int i = 0; i < 64; ++i) { s1 += lq[i] * lq[64 + i]; s2 += lq[128 + i] * lq[192 + i]; }
              lam = expf(s1) - expf(s2) + lam_init; }
            const int natt = need_ctx ? 1088 : 1024;
            for (int a = vcu; a < natt; a += G) {
                if (a < 1024) { const int bh = a >> 5, qb = a & 31, b = bh >> 3, h = bh & 7;
                    attn_unit(lds, U, TT, P.da_head_g + (size_t)l * DM, lam, 1.0f - lam_init, h, b * SEQ + 128 * qb, b * SEQ, 64, ML_ROWS + b * CTXL, 4); }
                else { const int bh = (a - 1024) >> 1, hf = a & 1, b = bh >> 3, h = bh & 7;
                    attn_unit(lds, U, TT, P.da_head_g + (size_t)l * DM, lam, 1.0f - lam_init, h, ML_ROWS + b * CTXL + 128 * hf, ML_ROWS + b * CTXL, 4, 0, 0); }
            }
        }
        xcd_barrier(xbar);
        {
            const int nm2 = need_ctx ? 16 * NCH : 16 * 32;
            for (int u = vcu; u < nm2; u += G) { const int bh = need_ctx ? u / NCH : u >> 5, loc = need_ctx ? u % NCH : 2 + (u & 31); mlstm_out_unit(lds, U, TT, GG, CT, NST, MST, P.ml_head_g + (size_t)l * DM, bh >> 2, bh & 3, loc); }
            __syncthreads();
            {
                const int f1c = (G == 256 && need_ctx) ? ((bx & 7) ? bx - (bx >> 3) - 1 : 224 + (bx >> 3) + 48) : bx;
                pg8::Sched S; S.init(Wc, U + U_FN, 256, LDU, 2, 16, 16, 4, 0, 0, (size_t)SEQ * LDU * 2, 512, (G == 256 && need_ctx) ? 224 : G, f1c, false);
                S.fold = true; S.nwg = 17 * 16;
                EpiF1Fold E{AT};
                pg8::gemm_phase(lds, pg8::Gemm{256, LDU, 256}, S, E);
            }
            if (need_ctx) {
                pg8::Sched S; S.init(Wc, U + (size_t)ML_ROWS * LDU + U_FN, 256, LDU, 2, 1, 16, 4, 0, 0, (size_t)CTXL * LDU * 2, 512, G, bx, false);
                EpiF1 E{ATC, CTXL};
                pg8::gemm_phase(lds, pg8::Gemm{256, LDU, 256}, S, E);
            }
            if (l + 1 < DEPTH && (G != 256 || (bx & 7))) convert_dynamic(P, lds, l + 1, 0, 10, CTR + 4 * l, 1);
        }
        xcd_barrier(xbar);
        {
            {
                pg8::Sched S; S.init(Dm, AT, 4096, 4096, 16, 4, 4, 1, 0, 0, (size_t)1024 * 4096 * 2, 0, G, bx, false);
                EpiF2 E{U, 0, SEQ};
                pg8::gemm_phase(lds, pg8::Gemm{4096, 4096, 4096}, S, E);
            }
            if (need_ctx) {
                pg8::Sched S; S.init(Dc, ATC, 512, 512, 1, 4, 4, 1, 0, 0, (size_t)1024 * 512 * 2, 0, G, bx, false);
                EpiF2 E{U, ML_ROWS, CTXL};
                pg8::gemm_phase(lds, pg8::Gemm{512, 512, 512}, S, E);
            }
        }
        xcd_barrier(xbar);
        {
            { pg8::Sched S; S.init(U + U_OG, WBR, LDU, DM, 64, 4, 1, 1, 0, 0, 0, 0, G, bx, true); EpiMerge<0> E{U, (bf16_t*)Y, AB}; pg8::gemm_phase(lds, pg8::Gemm{LDU, DM, DM}, S, E); }
            { pg8::Sched S; S.init(U + U_DAQ, WBR + (size_t)DM * DM, LDU, DM, 64, 4, 1, 1, 0, 0, 0, 0, G, bx, true); EpiMerge<1> E{U, (bf16_t*)Y, AB}; pg8::gemm_phase(lds, pg8::Gemm{LDU, DM, DM}, S, E); }
            { pg8::Sched S; S.init(U + U_FN, WBR + (size_t)2 * DM * DM, LDU, DM, 64, 4, 1, 1, 0, 0, 0, 0, G, bx, true); EpiMerge<2> E{U, (bf16_t*)Y, AB}; pg8::gemm_phase(lds, pg8::Gemm{LDU, DM, DM}, S, E); }
            if (need_ctx) {
                const bf16_t* Uc = U + (size_t)ML_ROWS * LDU;
                { pg8::Sched S; S.init(Uc + U_OG, WBR, LDU, DM, 4, 4, 1, 1, 0, 0, 0, 0, G, (bx + 48) % G, false); EpiMergeCtx E{U, YC, 0}; pg8::gemm_phase(lds, pg8::Gemm{LDU, DM, DM}, S, E); }
                { pg8::Sched S; S.init(Uc + U_DAQ, WBR + (size_t)DM * DM, LDU, DM, 4, 4, 1, 1, 0, 0, 0, 0, G, (bx + 32) % G, false); EpiMergeCtx E{U, YC + (size_t)MC_ROWS * DM, 1}; pg8::gemm_phase(lds, pg8::Gemm{LDU, DM, DM}, S, E); }
                { pg8::Sched S; S.init(Uc + U_FN, WBR + (size_t)2 * DM * DM, LDU, DM, 4, 4, 1, 1, 0, 0, 0, 0, G, (bx + 16) % G, false); EpiMergeCtx E{U, YC + (size_t)2 * MC_ROWS * DM, 2}; pg8::gemm_phase(lds, pg8::Gemm{LDU, DM, DM}, S, E); }
            }
            if (l + 1 < DEPTH) convert_dynamic(P, lds, l + 1, 0, 10, CTR + 4 * l);
        }
        xcd_barrier(xbar);
        if (need_ctx) {
            int t5 = threadIdx.x; asm volatile("" : "+v"(t5)); const int l5 = t5 & 63, gw5 = bx * 8 + (t5 >> 6);
            for (int row = gw5; row < MC_ROWS; row += NGW) {
#pragma unroll
                for (int j = 0; j < 4; ++j) { const size_t o = (size_t)row * DM + 4 * l5 + 256 * j;
                    const f32x4 y = *(const f32x4*)(YC + o) + *(const f32x4*)(YC + (size_t)MC_ROWS * DM + o) + *(const f32x4*)(YC + (size_t)2 * MC_ROWS * DM + o);
                    u32x2 w; w.x = cvt_pk_bf16(y[0], y[1]); w.y = cvt_pk_bf16(y[2], y[3]); *(u32x2*)(AB + (size_t)(ML_ROWS + row) * DM + 4 * l5 + 256 * j) = w; }
            }
            xcd_barrier(xbar);
        }
        {
            pg8::Sched S; S.init(AB, WOUT, DM, DM, 64, 4, 1, 1, 0, 0, 0, 0, G, bx, true);
            EpiResid E{srcL, srcC, P.out, XC, mods + 2 * 1024};
            pg8::gemm_phase(lds, pg8::Gemm{DM, DM, DM}, S, E);
            if (need_ctx) {
                pg8::Sched S2; S2.init(AB + (size_t)ML_ROWS * DM, WOUT, DM, DM, 4, 4, 2, 1, 1024, 0, 1024, 0, G, (bx + 112) % G, false);
                EpiResidCtxHalf E2{XC, TP6, mods + 4 * 6144 + 2 * 1024};
                pg8::gemm_phase(lds, pg8::Gemm{DM, DM, 512}, S2, E2);
            }
            if (l + 1 < DEPTH) convert_dynamic(P, lds, l + 1, 10, 13, CTR + 4 * l + 1);
        }
        xcd_barrier(xbar);
        {
            const int nrows = need_ctx ? MROWS : ML_ROWS;
            int tid7 = threadIdx.x; asm volatile("" : "+v"(tid7)); const int lane = tid7 & 63, gw = bx * 8 + (tid7 >> 6);
            for (int row = gw; row < nrows; row += NGW) { const bool lat = row < ML_ROWS; const int s = lat ? row >> 12 : 4;
                const float* xr = lat ? P.out + (size_t)row * DM : XC + (size_t)(row - ML_ROWS) * DM;
                if (lat) norm_mod_row(xr, P.norm_g + (size_t)(l * 2 + 1) * DM, mods + s * 6144 + 3 * 1024, mods + s * 6144 + 4 * 1024, AB + (size_t)row * DM, lane);
                else norm_mod_row(xr, P.norm_g + (size_t)(l * 2 + 1) * DM, mods + s * 6144 + 3 * 1024, mods + s * 6144 + 4 * 1024, AB + (size_t)row * DM, lane, TP6 + (size_t)(row - ML_ROWS) * DM, XC + (size_t)(row - ML_ROWS) * DM); }
        }
        xcd_barrier(xbar);
        {
            pg8::Sched S; S.init(AB, WF1, DM, DM, nMr, 22, 1, 1, 0, 0, 0, 0, G, bx, true);
            EpiSwiglu E{HID};
            pg8::gemm_phase(lds, pg8::Gemm{DM, DM, DM}, S, E);
        }
        xcd_barrier(xbar);
        {
            pg8::Sched S; S.init(HID, WF2, DFF, DFF, 64, 4, 1, 1, 0, 0, 0, 0, G, bx, true);
            EpiResid E{P.out, XC, P.out, XC, mods + 5 * 1024};
            pg8::gemm_phase(lds, pg8::Gemm{DFF, DFF, DFF}, S, E);
            if (need_ctx) {
                pg8::Sched S2; S2.init(HID + (size_t)ML_ROWS * DFF, WF2, DFF, DFF, 4, 4, 2, 1, 2816, 0, 2816, 0, G, (bx + 112) % G, false);
                EpiResidCtxHalf E2{XC, TP9, mods + 4 * 6144 + 5 * 1024};
                pg8::gemm_phase(lds, pg8::Gemm{DFF, DFF, 1408}, S2, E2);
            }
            if (l + 1 < DEPTH) convert_dynamic(P, lds, l + 1, 13, 15, CTR + 4 * l + 2);
        }
        xcd_barrier(xbar);
    }
    int tidf = threadIdx.x; asm volatile("" : "+v"(tidf));
    const int lane = tidf & 63, gw = bx * 8 + (tidf >> 6);
    for (int row = gw; row < ML_ROWS; row += NGW) {
        float* xr = P.out + (size_t)row * DM; f32x4 v[4]; float s = 0.f;
#pragma unroll
        for (int j = 0; j < 4; ++j) { v[j] = *(const f32x4*)(xr + 4 * lane + 256 * j); s += (v[j][0] * v[j][0] + v[j][1] * v[j][1]) + (v[j][2] * v[j][2] + v[j][3] * v[j][3]); }
        const float rn = 1.0f / sqrtf(wave_sum(s) * (1.0f / DM) + EPS);
#pragma unroll
        for (int j = 0; j < 4; ++j) *(f32x4*)(xr + 4 * lane + 256 * j) = v[j] * rn * *(const f32x4*)(P.final_g + 4 * lane + 256 * j);
    }
}

extern "C" void kernel_launch(void* const* d_in, const int* in_sizes, int n_in, void* d_out, int out_size, void* d_ws, size_t ws_size, hipStream_t stream) {
    static int grid_blocks = 0;
    if (grid_blocks == 0) {
        if (n_in != 19 || ws_size < WS_END) { fprintf(stderr, "kernel_launch: need 19 inputs and %zu bytes of workspace (got %d, %zu)\n", (size_t)WS_END, n_in, ws_size); grid_blocks = -1; return; }
        int dev = 0, cus = 0, per_cu = 0;
        hipGetDevice(&dev);
        hipDeviceGetAttribute(&cus, hipDeviceAttributeMultiprocessorCount, dev);
        hipFuncSetAttribute((const void*)fwd_megakernel, hipFuncAttributeMaxDynamicSharedMemorySize, LDS_BYTES);
        hipOccupancyMaxActiveBlocksPerMultiprocessor(&per_cu, (const void*)fwd_megakernel, 512, LDS_BYTES);
        if (per_cu < 1) per_cu = 1;
        grid_blocks = cus * per_cu;
    }
    if (grid_blocks < 0) return;
    Params p{};
    const float** pp = (const float**)&p;
    for (int i = 0; i < 19; ++i) pp[i] = (const float*)d_in[i];
    p.out = (float*)d_out; p.ws = (unsigned char*)d_ws;
    (void)hipMemsetAsync((char*)d_ws + WS_CTR, 0, 256 + 3456 * 4, stream);
    void* args[] = {&p};
    hipError_t e = hipLaunchCooperativeKernel((const void*)fwd_megakernel, dim3(grid_blocks), dim3(512), args, LDS_BYTES, stream);
    if (e != hipSuccess) fprintf(stderr, "cooperative launch failed: %s (grid %d)\n", hipGetErrorString(e), grid_blocks);
}
```

```cpp
#include <hip/hip_runtime.h>
#include <hip/hip_cooperative_groups.h>
#include <cstdio>
#include <cstdint>
namespace cg = cooperative_groups;

#define LAS __attribute__((address_space(3)))
typedef unsigned short bf16_t;
typedef short bf16x8 __attribute__((ext_vector_type(8)));
typedef float f32x4 __attribute__((ext_vector_type(4)));
typedef float f32x2 __attribute__((ext_vector_type(2)));
typedef unsigned u32x4 __attribute__((ext_vector_type(4)));
typedef unsigned u32x2 __attribute__((ext_vector_type(2)));
typedef LAS unsigned char* ldsp;

constexpr int DM = 1024, NB = 4, SEQ = 4096, CTXL = 256, DEPTH = 4;
constexpr int ML_ROWS = NB * SEQ;
constexpr int MC_ROWS = NB * CTXL;
constexpr int MROWS = ML_ROWS + MC_ROWS;
constexpr int DIN = 11280, DFF = 2816;
constexpr float EPS = 1e-6f;
constexpr int LDU = 9216;
constexpr int U_GP = 0, U_FN = 3072, U_DAK = 4096, U_DAQ = 5120, U_OG = 6144, U_MLQ = 7168, U_MLK = 8192;
constexpr int WIN_ROWS = 11520, WIN_MAIN = 9472, WIN_MLV = 9472, WIN_DAV = 10496;
constexpr int LDT = MROWS;
constexpr int NCH = 34;
constexpr float QSCALE = 0.125f * 1.4426950408889634f;

constexpr size_t MiB = 1u << 20;
constexpr size_t WS_WIN = 0;
constexpr size_t WS_WBR = WS_WIN + (size_t)WIN_ROWS * DM * 2;
constexpr size_t WS_WOUT = WS_WBR + 3 * (size_t)DM * DM * 2;
constexpr size_t WS_WF1 = WS_WOUT + (size_t)DM * DM * 2;
constexpr size_t WS_WF2 = WS_WF1 + (size_t)2 * DFF * DM * 2;
constexpr size_t WS_WEND = WS_WF2 + (size_t)DM * DFF * 2;
constexpr size_t WS_U = 52 * MiB;
constexpr size_t WS_TT = WS_U + (size_t)MROWS * LDU * 2;
constexpr size_t WS_XC = WS_TT + (size_t)2048 * LDT * 2;
constexpr size_t WS_AB = WS_XC + (size_t)MC_ROWS * DM * 4;
constexpr size_t WS_ATC = WS_AB + (size_t)NB * 1024 * 8192 * 2;
constexpr size_t WS_KT = WS_AB + (size_t)34 * MiB;
static_assert(WS_KT >= WS_AB + (size_t)MROWS * DM * 2 && WS_KT + (size_t)1024 * LDT * 2 <= WS_ATC + (size_t)NB * 1024 * 512 * 2, "KT overlay");
constexpr size_t WS_D = WS_ATC + (size_t)NB * 1024 * 512 * 2;
constexpr size_t WS_DC = WS_D + (size_t)4096 * 8192 * 2;
constexpr size_t WS_WC = WS_DC + (size_t)256 * 512 * 2;
constexpr size_t WS_ROPE = WS_WC + (size_t)512 * 256 * 2;
constexpr size_t WS_MODS = WS_ROPE + (size_t)4096 * 64 * 4;
constexpr size_t WS_G = WS_MODS + (size_t)DEPTH * 5 * 6144 * 4;
constexpr size_t WS_NST = WS_G + (size_t)MROWS * 16 * 4;
constexpr size_t WS_MST = WS_NST + (size_t)32 * NCH * 256 * 4;
constexpr size_t WS_CTR = WS_MST + 32 * NCH * 4;
constexpr size_t WS_BAR = WS_CTR + 256;
constexpr size_t WS_CT = ((WS_BAR + 3456 * 4 + 255) / 256) * 256;
constexpr size_t WS_END = WS_CT + (size_t)32 * NCH * 65536 * 2;
static_assert(WS_WEND <= WS_U, "weights fit");
static_assert((size_t)MROWS * DM * 4 <= (size_t)32 * NCH * 65536 * 2, "Y overlay fits");
static_assert((size_t)MROWS * DFF * 2 <= (size_t)MROWS * LDU * 2, "hidden overlay fits");

constexpr int LDS_BYTES = 155648;

__device__ __forceinline__ unsigned cvt_pk_bf16(float lo, float hi) { unsigned r; asm volatile("v_cvt_pk_bf16_f32 %0, %1, %2" : "=v"(r) : "v"(lo), "v"(hi)); return r; }
__device__ __forceinline__ float bf2f(bf16_t v) { return __uint_as_float((unsigned)v << 16); }
__device__ __forceinline__ float sigmoidf_(float x) { return 1.0f / (1.0f + __expf(-x)); }
__device__ __forceinline__ f32x4 mfma16(bf16x8 a, bf16x8 b, f32x4 c) { return __builtin_amdgcn_mfma_f32_16x16x32_bf16(a, b, c, 0, 0, 0); }
__device__ __forceinline__ float wave_sum(float v) {
#pragma unroll
    for (int o = 1; o < 64; o <<= 1) v += __shfl_xor(v, o);
    return v;
}

namespace pg8 {
constexpr int BM = 256, BK = 64, HALF = 128, HTB = HALF * BK * 2, STAGE_BYTES = 8 * HTB, NXCD = 8, WGM = 8;
__host__ __device__ __forceinline__ int lds_byte(int r, int c) { const int st = (r >> 4) * 2 + (c >> 5), rr = r & 15, cc = c & 31, ob = rr * 64 + cc * 2; return st * 1024 + (ob ^ (((ob >> 9) & 1) << 5)); }
__host__ __device__ __forceinline__ void stage_rc(int b, int& R, int& C) { const int st = b / 1024, sb = b % 1024, swz = sb ^ (((sb >> 9) & 1) << 5); R = (st >> 1) * 16 + swz / 64; C = (st & 1) * 32 + (swz % 64) / 2; }
__host__ __device__ __forceinline__ int perm32(int rho) { const int n = rho >> 4, i = rho & 15; return 8 * (i >> 2) + 4 * n + (i & 3); }

struct Unit { const char* A; const char* B; int pm, pn, job; };
struct Gemm { int lda, ldb, K; };

struct Sched {
    const char* A0; const char* B0; size_t tA, tB, s1A, s2A, s1B, s2B; int nM, nN, nj2, nwg, G, c; bool swz; bool fold;
    __device__ __forceinline__ void init(const void* A, const void* B, int lda, int ldb, int nM_, int nN_, int njobs, int nj2_, size_t s1A_, size_t s2A_, size_t s1B_, size_t s2B_, int G_, int c_, bool swz_) {
        A0 = (const char*)A; B0 = (const char*)B; tA = (size_t)BM * lda * 2; tB = (size_t)BM * ldb * 2; s1A = s1A_; s2A = s2A_; s1B = s1B_; s2B = s2B_;
        nM = nM_; nN = nN_; nj2 = nj2_; nwg = nM_ * nN_ * njobs; G = G_; c = c_; swz = swz_; fold = false;
    }
    __device__ __forceinline__ bool next(int i, Unit& u) const {
        const long L = (long)i * G + c; if (L >= nwg) return false;
        int wgid = (int)L, job = 0, pm, pn;
        if (swz) {
            { const int q = nwg / NXCD, r = nwg % NXCD, xcd = wgid % NXCD, off = wgid / NXCD; wgid = (xcd < r ? xcd * (q + 1) : r * (q + 1) + (xcd - r) * q) + off; }
            const int nig = WGM * nN, gid = wgid / nig, fm = gid * WGM, gsz = (nM - fm) < WGM ? (nM - fm) : WGM;
            pm = fm + ((wgid % nig) % gsz); pn = (wgid % nig) / gsz;
        } else {
            if (fold) { job = wgid / 17; const int rem = wgid - job * 17; pm = rem < 9 ? 0 : 1; pn = rem < 9 ? rem : rem - 1; }
            else { const int per = nM * nN; job = wgid / per; const int rem = wgid - job * per; pn = rem / nM; pm = rem - pn * nM; }
        }
        const int j1 = job / nj2, j2 = job - j1 * nj2;
        u.pm = pm; u.pn = pn; u.job = job;
        u.A = A0 + (size_t)j1 * s1A + (size_t)j2 * s2A + (size_t)pm * tA;
        u.B = B0 + (size_t)j1 * s1B + (size_t)j2 * s2B + (size_t)pn * tB;
        return true;
    }
};

template <class Epi>
__device__ __forceinline__ void gemm_phase(ldsp lds, const Gemm g, const Sched& S, const Epi& E) {
    int tid = threadIdx.x; asm volatile("" : "+v"(tid)); const int wid = __builtin_amdgcn_readfirstlane(tid >> 6), lane = tid & 63, wr = wid >> 2, wc = wid & 3, fr = lane & 15, fq = lane >> 4;
    int K = g.K; asm volatile("" : "+s"(K)); const int nt = K / BK;
    unsigned voffA[2], voffB[2];
#pragma unroll
    for (int i = 0; i < 2; ++i) { int R, C; stage_rc(tid * 16 + i * 8192, R, C); const int Rb = (R & ~31) + perm32(R & 31);
        voffA[i] = (unsigned)(R * g.lda + C) * 2u; voffB[i] = (unsigned)(Rb * g.ldb + C) * 2u; }
    const size_t kstep = (size_t)(BK * 2);
    const size_t hstepA = (size_t)HALF * g.lda * 2, hstepB = (size_t)HALF * g.ldb * 2;
    const unsigned ldsw = (unsigned)wid * 1024u;
    const int aoff = lds_byte(wr * 64 + fr, fq * 8), boff = lds_byte(wc * 32 + fr, fq * 8);
#define PG8_SA(b, h) (((b) * 2 + (h)) * HTB)
#define PG8_SB(b, h) ((4 + (b) * 2 + (h)) * HTB)
#define PG8_STAGE(bufoff, gbase, voff) do { _Pragma("unroll") for (int _i = 0; _i < 2; ++_i) \
        __builtin_amdgcn_global_load_lds((const unsigned*)((const char*)(gbase) + (voff)[_i]), (LAS unsigned*)(lds + (bufoff) + ldsw + _i * 8192), 16, 0, 0); } while (0)
#define PG8_LDA(dst, b, h) do { _Pragma("unroll") for (int m = 0; m < 4; ++m) _Pragma("unroll") for (int k = 0; k < 2; ++k) dst[m][k] = *(const LAS bf16x8*)(lds + PG8_SA(b, h) + aoff + m * 2048 + k * 1024); } while (0)
#define PG8_LDB(dst, b, h) do { _Pragma("unroll") for (int n = 0; n < 2; ++n) _Pragma("unroll") for (int k = 0; k < 2; ++k) dst[n][k] = *(const LAS bf16x8*)(lds + PG8_SB(b, h) + boff + n * 2048 + k * 1024); } while (0)
#define PG8_MMA(ai, bj, At, Bt) do { __builtin_amdgcn_s_setprio(1); _Pragma("unroll") for (int m = 0; m < 4; ++m) _Pragma("unroll") for (int n = 0; n < 2; ++n) _Pragma("unroll") for (int k = 0; k < 2; ++k) \
        acc[ai][bj][m][n] = __builtin_amdgcn_mfma_f32_16x16x32_bf16(Bt[n][k], At[m][k], acc[ai][bj][m][n], 0, 0, 0); __builtin_amdgcn_s_setprio(0); } while (0)
#define PG8_WAIT_V(n) asm volatile("s_waitcnt vmcnt(" #n ")" ::: "memory")
#define PG8_WAIT_L(n) asm volatile("s_waitcnt lgkmcnt(" #n ")" ::: "memory")
#define PG8_BAR __builtin_amdgcn_s_barrier()
#define PG8_SCHED __builtin_amdgcn_sched_barrier(0)
    Unit cur, nxt; int ui = 0;
    if (!S.next(0, cur)) return;
    f32x4 acc[2][2][4][2];
#pragma unroll
    for (int a = 0; a < 2; ++a)
#pragma unroll
        for (int b = 0; b < 2; ++b)
#pragma unroll
            for (int m = 0; m < 4; ++m)
#pragma unroll
                for (int n = 0; n < 2; ++n) acc[a][b][m][n] = (f32x4){0.f, 0.f, 0.f, 0.f};
    bf16x8 At[4][2], B0[2][2], B1[2][2];
    const char* cA = cur.A; const char* cB = cur.B;
    PG8_STAGE(PG8_SB(0, 0), cB, voffB); PG8_STAGE(PG8_SB(0, 1), cB + hstepB, voffB); PG8_STAGE(PG8_SA(0, 0), cA, voffA); PG8_STAGE(PG8_SA(0, 1), cA + hstepA, voffA);
    if (wr == 1) PG8_BAR;
    PG8_WAIT_V(2); PG8_BAR;
    PG8_STAGE(PG8_SB(1, 0), cB + kstep, voffB); PG8_STAGE(PG8_SA(1, 0), cA + kstep, voffA); PG8_STAGE(PG8_SB(1, 1), cB + hstepB + kstep, voffB);
    PG8_WAIT_V(6); PG8_BAR;
    for (;;) {
        const bool has_next = S.next(ui + 1, nxt);
        const char* nA = has_next ? nxt.A : cA; const char* nB = has_next ? nxt.B : cB;
#pragma unroll 1
        for (int t = 0; t < nt; t += 2) {
            const bool last = (t == nt - 2);
            const char* a1 = cA + (size_t)(t + 1) * kstep;
            const char* a2 = last ? nA : cA + (size_t)(t + 2) * kstep; const char* b2 = last ? nB : cB + (size_t)(t + 2) * kstep;
            const char* a3 = a2 + kstep; const char* b3 = b2 + kstep;
            PG8_LDB(B0, 0, 0); PG8_LDB(B1, 0, 1); PG8_SCHED; PG8_LDA(At, 0, 0); PG8_STAGE(PG8_SA(1, 1), a1 + hstepA, voffA);
            PG8_WAIT_V(8); PG8_WAIT_L(0); PG8_BAR; PG8_MMA(0, 0, At, B0); PG8_MMA(0, 1, At, B1); PG8_BAR; PG8_SCHED;
            PG8_LDA(At, 0, 1); PG8_STAGE(PG8_SB(0, 0), b2, voffB); PG8_STAGE(PG8_SB(0, 1), b2 + hstepB, voffB); PG8_STAGE(PG8_SA(0, 0), a2, voffA);
            PG8_WAIT_V(8); PG8_WAIT_L(0); PG8_BAR; PG8_MMA(1, 0, At, B0); PG8_MMA(1, 1, At, B1); PG8_BAR; PG8_SCHED;
            PG8_LDB(B0, 1, 0); PG8_LDB(B1, 1, 1); PG8_SCHED; PG8_LDA(At, 1, 0); PG8_STAGE(PG8_SA(0, 1), a2 + hstepA, voffA);
            PG8_WAIT_V(8); PG8_WAIT_L(0); PG8_BAR; PG8_MMA(0, 0, At, B0); PG8_MMA(0, 1, At, B1); PG8_BAR; PG8_SCHED;
            PG8_LDA(At, 1, 1); PG8_STAGE(PG8_SB(1, 0), b3, voffB); PG8_STAGE(PG8_SB(1, 1), b3 + hstepB, voffB); PG8_STAGE(PG8_SA(1, 0), a3, voffA);
            PG8_WAIT_V(8); PG8_WAIT_L(0); PG8_BAR; PG8_MMA(1, 0, At, B0); PG8_MMA(1, 1, At, B1); PG8_BAR; PG8_SCHED;
        }
        if (wr == 0) PG8_BAR;
        E(acc, cur, wr, wc, fr, fq);
        if (!has_next) break;
#pragma unroll
        for (int a = 0; a < 2; ++a)
#pragma unroll
            for (int b = 0; b < 2; ++b)
#pragma unroll
                for (int m = 0; m < 4; ++m)
#pragma unroll
                    for (int n = 0; n < 2; ++n) acc[a][b][m][n] = (f32x4){0.f, 0.f, 0.f, 0.f};
        cur = nxt; cA = nA; cB = nB; ++ui;
        if (wr == 1) PG8_BAR;
    }
    PG8_WAIT_V(0);
    PG8_BAR;
#undef PG8_SA
#undef PG8_SB
#undef PG8_STAGE
#undef PG8_LDA
#undef PG8_LDB
#undef PG8_MMA
#undef PG8_WAIT_V
#undef PG8_WAIT_L
#undef PG8_BAR
#undef PG8_SCHED
}
}
using pg8::Unit;

#define EPI_BEGIN(acc, wr, wc, fr, fq) \
    _Pragma("unroll") for (int ai = 0; ai < 2; ++ai) _Pragma("unroll") for (int m = 0; m < 4; ++m) _Pragma("unroll") for (int bj = 0; bj < 2; ++bj) { \
        const int rt = ai * 128 + wr * 64 + m * 16 + fr, ct = bj * 128 + wc * 32 + fq * 8; f32x4 v0 = acc[ai][bj][m][0], v1 = acc[ai][bj][m][1];
#define EPI_END }

__device__ __forceinline__ u32x4 pack8(f32x4 v0, f32x4 v1) { u32x4 w; w.x = cvt_pk_bf16(v0[0], v0[1]); w.y = cvt_pk_bf16(v0[2], v0[3]); w.z = cvt_pk_bf16(v1[0], v1[1]); w.w = cvt_pk_bf16(v1[2], v1[3]); return w; }

struct EpiInproj {
    bf16_t* U; float* G; const float* gate_b; const float* rope;
    __device__ __forceinline__ void operator()(const f32x4 (&acc)[2][2][4][2], const Unit& u, int wr, int wc, int fr, int fq) const {
        const int row0 = u.pm * 256;
        if (u.pn == 0) {
            if (wc == 0 && fq < 2) {
                f32x4 b0 = *(const f32x4*)(gate_b + 8 * fq), b1 = *(const f32x4*)(gate_b + 8 * fq + 4);
#pragma unroll
                for (int ai = 0; ai < 2; ++ai)
#pragma unroll
                    for (int m = 0; m < 4; ++m) { const int row = row0 + ai * 128 + wr * 64 + m * 16 + fr;
                        *(f32x4*)(G + (size_t)row * 16 + 8 * fq) = acc[ai][0][m][0] + b0; *(f32x4*)(G + (size_t)row * 16 + 8 * fq + 4) = acc[ai][0][m][1] + b1; }
            }
            return;
        }
        const int ucol0 = (u.pn - 1) * 256;
        const int seg = ucol0 < U_FN ? 0 : (ucol0 >> 10);
        const bool latent = row0 < ML_ROWS;
        EPI_BEGIN(acc, wr, wc, fr, fq) {
            const int row = row0 + rt, col = ucol0 + ct;
            if (seg == 0 || seg == 6) {
#pragma unroll
                for (int j = 0; j < 4; ++j) { v0[j] = sigmoidf_(v0[j]); v1[j] = sigmoidf_(v1[j]); }
            } else if (seg == 4 || seg == 5) {
                if (latent) {
                    const int t = row & (SEQ - 1), ib = (col & 63) >> 1;
                    const f32x4 cs0 = *(const f32x4*)(rope + ((size_t)t * 32 + ib) * 2), cs1 = *(const f32x4*)(rope + ((size_t)t * 32 + ib) * 2 + 4);
                    f32x4 w0, w1;
                    w0[0] = v0[0] * cs0[0] - v0[1] * cs0[1]; w0[1] = v0[0] * cs0[1] + v0[1] * cs0[0];
                    w0[2] = v0[2] * cs0[2] - v0[3] * cs0[3]; w0[3] = v0[2] * cs0[3] + v0[3] * cs0[2];
                    w1[0] = v1[0] * cs1[0] - v1[1] * cs1[1]; w1[1] = v1[0] * cs1[1] + v1[1] * cs1[0];
                    w1[2] = v1[2] * cs1[2] - v1[3] * cs1[3]; w1[3] = v1[2] * cs1[3] + v1[3] * cs1[2];
                    v0 = w0; v1 = w1;
                }
                if (seg == 5) { v0 = v0 * QSCALE; v1 = v1 * QSCALE; }
            } else if (seg == 8) { v0 = v0 * 0.0625f; v1 = v1 * 0.0625f; }
            *(u32x4*)(U + (size_t)row * LDU + col) = pack8(v0, v1);
        } EPI_END
    }
};
struct EpiTT {
    bf16_t* TT; bf16_t* KT;
    __device__ __forceinline__ void operator()(const f32x4 (&acc)[2][2][4][2], const Unit& u, int wr, int wc, int fr, int fq) const {
        bf16_t* base = u.pm < 4 ? KT + (size_t)(u.pm * 256) * LDT : TT + (size_t)((u.pm - 4) * 256) * LDT;
        const float sc = u.pm < 4 ? 0.0625f : 1.0f;
        if (u.pm < 8) {
            EPI_BEGIN(acc, wr, wc, fr, fq) { *(u32x4*)(base + (size_t)rt * LDT + u.pn * 256 + ct) = pack8(v0 * sc, v1 * sc); } EPI_END
        } else {
            EPI_BEGIN(acc, wr, wc, fr, fq) {
                const int m8 = (ct >> 3) & 3, hh = m8 >> 1, q0 = 2 * (m8 & 1);
                bf16_t* p = base + (size_t)rt * LDT + u.pn * 256 + (ct & ~31);
                u32x2 w0; w0.x = cvt_pk_bf16(v0[0], v0[1]); w0.y = cvt_pk_bf16(v0[2], v0[3]);
                u32x2 w1; w1.x = cvt_pk_bf16(v1[0], v1[1]); w1.y = cvt_pk_bf16(v1[2], v1[3]);
                *(u32x2*)(p + 8 * q0 + 4 * hh) = w0; *(u32x2*)(p + 8 * (q0 + 1) + 4 * hh) = w1;
            } EPI_END
        }
    }
};
struct EpiF1 {
    bf16_t* AT; int Tn;
    __device__ __forceinline__ void operator()(const f32x4 (&acc)[2][2][4][2], const Unit& u, int wr, int wc, int fr, int fq) const {
        const int b = u.job >> 2, g = u.job & 3;
        EPI_BEGIN(acc, wr, wc, fr, fq) { *(u32x4*)(AT + ((size_t)((b * 1024 + 256 * g + rt) * 2 + u.pm)) * Tn + u.pn * 256 + ct) = pack8(v0, v1); } EPI_END
    }
};
struct EpiF1Fold {
    bf16_t* AT;
    __device__ __forceinline__ void operator()(const f32x4 (&acc)[2][2][4][2], const Unit& u, int wr, int wc, int fr, int fq) const {
        const int b = u.job >> 2, g = u.job & 3;
        EPI_BEGIN(acc, wr, wc, fr, fq) {
            bf16_t* p = AT + (size_t)(b * 1024 + 256 * g + rt) * 4096 + u.pn * 256 + ct;
            const u32x4 w = pack8(v0, v1);
            if (u.pn != 8) *(u32x4*)p = w;
            else if (u.pm == 0) { if (ct == 0) p[0] = (bf16_t)(w.x & 0xffffu); }
            else { if (ct != 0) *(u32x4*)p = w;
                   else { p[1] = (bf16_t)(w.x >> 16); *(unsigned*)(p + 2) = w.y; *(unsigned*)(p + 4) = w.z; *(unsigned*)(p + 6) = w.w; } }
        } EPI_END
    }
};
struct EpiF2 {
    bf16_t* U; int rowbase, Tn;
    __device__ __forceinline__ void operator()(const f32x4 (&acc)[2][2][4][2], const Unit& u, int wr, int wc, int fr, int fq) const {
        EPI_BEGIN(acc, wr, wc, fr, fq) { *(u32x4*)(U + (size_t)(rowbase + u.job * Tn + u.pm * 256 + rt) * LDU + U_FN + u.pn * 256 + ct) = pack8(v0, v1); } EPI_END
    }
};
template <int PASS> struct EpiMerge {
    const bf16_t* U; bf16_t* Y; bf16_t* AB;
    __device__ __forceinline__ void operator()(const f32x4 (&acc)[2][2][4][2], const Unit& u, int wr, int wc, int fr, int fq) const {
        EPI_BEGIN(acc, wr, wc, fr, fq) {
            const int row = u.pm * 256 + rt, col = u.pn * 256 + ct;
            const u32x4 gw = *(const u32x4*)(U + (size_t)row * LDU + U_GP + 1024 * PASS + col);
            f32x4 g0, g1;
            g0[0] = __uint_as_float(gw.x << 16); g0[1] = __uint_as_float(gw.x & 0xffff0000u); g0[2] = __uint_as_float(gw.y << 16); g0[3] = __uint_as_float(gw.y & 0xffff0000u);
            g1[0] = __uint_as_float(gw.z << 16); g1[1] = __uint_as_float(gw.z & 0xffff0000u); g1[2] = __uint_as_float(gw.w << 16); g1[3] = __uint_as_float(gw.w & 0xffff0000u);
            v0 = v0 * g0; v1 = v1 * g1;
            bf16_t* yp = Y + (size_t)row * DM + col;
            if (PASS > 0) { const u32x4 yw = *(const u32x4*)yp;
                v0[0] += __uint_as_float(yw.x << 16); v0[1] += __uint_as_float(yw.x & 0xffff0000u); v0[2] += __uint_as_float(yw.y << 16); v0[3] += __uint_as_float(yw.y & 0xffff0000u);
                v1[0] += __uint_as_float(yw.z << 16); v1[1] += __uint_as_float(yw.z & 0xffff0000u); v1[2] += __uint_as_float(yw.w << 16); v1[3] += __uint_as_float(yw.w & 0xffff0000u); }
            if (PASS < 2) *(u32x4*)yp = pack8(v0, v1);
            else *(u32x4*)(AB + (size_t)row * DM + col) = pack8(v0, v1);
        } EPI_END
    }
};
struct EpiResid {
    const float* srcL; const float* srcC; float* dstL; float* dstC; const float* gate;
    __device__ __forceinline__ void operator()(const f32x4 (&acc)[2][2][4][2], const Unit& u, int wr, int wc, int fr, int fq) const {
        const bool lat = u.pm < 64; const int s = lat ? (u.pm >> 4) : 4;
        const float* src = lat ? srcL + (size_t)u.pm * 256 * DM : srcC + (size_t)(u.pm - 64) * 256 * DM;
        float* dst = lat ? dstL + (size_t)u.pm * 256 * DM : dstC + (size_t)(u.pm - 64) * 256 * DM;
        const float* gp = gate + (size_t)s * 6144;
        EPI_BEGIN(acc, wr, wc, fr, fq) {
            const int col = u.pn * 256 + ct; const size_t off = (size_t)rt * DM + col;
            const f32x4 g0 = *(const f32x4*)(gp + col), g1 = *(const f32x4*)(gp + col + 4);
            *(f32x4*)(dst + off) = *(const f32x4*)(src + off) + g0 * v0; *(f32x4*)(dst + off + 4) = *(const f32x4*)(src + off + 4) + g1 * v1;
        } EPI_END
    }
};
struct EpiResidCtxHalf {
    float* dstC; float* part; const float* gate;
    __device__ __forceinline__ void operator()(const f32x4 (&acc)[2][2][4][2], const Unit& u, int wr, int wc, int fr, int fq) const {
        float* dst = (u.job == 0 ? dstC : part) + (size_t)u.pm * 256 * DM;
        EPI_BEGIN(acc, wr, wc, fr, fq) {
            const int col = u.pn * 256 + ct; float* p = dst + (size_t)rt * DM + col;
            const f32x4 g0 = *(const f32x4*)(gate + col), g1 = *(const f32x4*)(gate + col + 4);
            if (u.job == 0) { *(f32x4*)p = *(const f32x4*)p + g0 * v0; *(f32x4*)(p + 4) = *(const f32x4*)(p + 4) + g1 * v1; }
            else { *(f32x4*)p = g0 * v0; *(f32x4*)(p + 4) = g1 * v1; }
        } EPI_END
    }
};
struct EpiMergeCtx {
    const bf16_t* U; float* Yc; int pass;
    __device__ __forceinline__ void operator()(const f32x4 (&acc)[2][2][4][2], const Unit& u, int wr, int wc, int fr, int fq) const {
        EPI_BEGIN(acc, wr, wc, fr, fq) {
            const int row = u.pm * 256 + rt, col = u.pn * 256 + ct;
            const u32x4 gw = *(const u32x4*)(U + (size_t)(ML_ROWS + row) * LDU + U_GP + 1024 * pass + col);
            f32x4 g0, g1;
            g0[0] = __uint_as_float(gw.x << 16); g0[1] = __uint_as_float(gw.x & 0xffff0000u); g0[2] = __uint_as_float(gw.y << 16); g0[3] = __uint_as_float(gw.y & 0xffff0000u);
            g1[0] = __uint_as_float(gw.z << 16); g1[1] = __uint_as_float(gw.z & 0xffff0000u); g1[2] = __uint_as_float(gw.w << 16); g1[3] = __uint_as_float(gw.w & 0xffff0000u);
            float* yp = Yc + (size_t)row * DM + col;
            *(f32x4*)yp = v0 * g0; *(f32x4*)(yp + 4) = v1 * g1;
        } EPI_END
    }
};
struct EpiSwiglu {
    bf16_t* H;
    __device__ __forceinline__ void operator()(const f32x4 (&acc)[2][2][4][2], const Unit& u, int wr, int wc, int fr, int fq) const {
#pragma unroll
        for (int ai = 0; ai < 2; ++ai)
#pragma unroll
            for (int m = 0; m < 4; ++m) {
                const int row = u.pm * 256 + ai * 128 + wr * 64 + m * 16 + fr, col = u.pn * 128 + wc * 32 + fq * 8;
                f32x4 h0, h1;
#pragma unroll
                for (int j = 0; j < 4; ++j) { const float a0 = acc[ai][0][m][0][j], a1 = acc[ai][0][m][1][j];
                    h0[j] = a0 * sigmoidf_(a0) * acc[ai][1][m][0][j]; h1[j] = a1 * sigmoidf_(a1) * acc[ai][1][m][1][j]; }
                *(u32x4*)(H + (size_t)row * DFF + col) = pack8(h0, h1);
            }
    }
};

__device__ __forceinline__ void norm_mod_row(const float* xr, const float* g, const float* shift, const float* scale, bf16_t* orow, int lane, const float* part = nullptr, float* xw = nullptr) {
    f32x4 v[4]; float s = 0.f;
#pragma unroll
    for (int j = 0; j < 4; ++j) { v[j] = *(const f32x4*)(xr + 4 * lane + 256 * j);
        if (part) { v[j] = v[j] + *(const f32x4*)(part + 4 * lane + 256 * j); *(f32x4*)(xw + 4 * lane + 256 * j) = v[j]; }
        s += (v[j][0] * v[j][0] + v[j][1] * v[j][1]) + (v[j][2] * v[j][2] + v[j][3] * v[j][3]); }
    const float rn = 1.0f / sqrtf(wave_sum(s) * (1.0f / DM) + EPS);
#pragma unroll
    for (int j = 0; j < 4; ++j) { const int c = 4 * lane + 256 * j;
        const f32x4 gg = *(const f32x4*)(g + c), sh = *(const f32x4*)(shift + c), sc = *(const f32x4*)(scale + c);
        f32x4 y = v[j] * rn * gg; y = y * (sc + 1.0f) + sh;
        u32x2 w; w.x = cvt_pk_bf16(y[0], y[1]); w.y = cvt_pk_bf16(y[2], y[3]); *(u32x2*)(orow + c) = w; }
}
__device__ __forceinline__ int dst_row(int perm, int n) {
    if (perm == 1) { const int d = n & 63; return (n & ~63) + (d < 32 ? 2 * d : 2 * (d - 32) + 1); }
    if (perm == 2) { const int j = n < DFF ? n : n - DFF; return 256 * (j >> 7) + (n < DFF ? 0 : 128) + (j & 127); }
    return n;
}
__device__ __forceinline__ void transpose_item(const float* W, int ldn, int src_off, int width, bf16_t* WT, int Kd, int row_off, int perm, LAS float* scr, int kb, int nb, int lane) {
    const int k0 = 64 * kb, n0 = 32 * nb; const bool okc = (n0 + (lane & 31)) < width;
#pragma unroll
    for (int i = 0; i < 32; ++i) { const int kk = 2 * i + (lane >> 5); scr[kk * 33 + (lane & 31)] = okc ? W[(size_t)(k0 + kk) * ldn + src_off + n0 + (lane & 31)] : 0.f; }
    asm volatile("s_waitcnt lgkmcnt(0)" ::: "memory");
    const int c = lane & 7;
#pragma unroll
    for (int j = 0; j < 4; ++j) { const int n = (lane >> 3) + 8 * j; const LAS float* s = scr + (8 * c) * 33 + n;
        u32x4 o; o.x = cvt_pk_bf16(s[0 * 33], s[1 * 33]); o.y = cvt_pk_bf16(s[2 * 33], s[3 * 33]); o.z = cvt_pk_bf16(s[4 * 33], s[5 * 33]); o.w = cvt_pk_bf16(s[6 * 33], s[7 * 33]);
        if (n0 + n < width) *(u32x4*)(WT + (size_t)(row_off + dst_row(perm, n0 + n)) * Kd + k0 + 8 * c) = o; }
    asm volatile("s_waitcnt lgkmcnt(0)" ::: "memory");
}

__device__ __forceinline__ float xmax16(float v) { auto r = __builtin_amdgcn_permlane16_swap(__float_as_uint(v), __float_as_uint(v), false, false); return fmaxf(__uint_as_float(r[0]), __uint_as_float(r[1])); }
__device__ __forceinline__ float xmax32(float v) { auto r = __builtin_amdgcn_permlane32_swap(__float_as_uint(v), __float_as_uint(v), false, false); return fmaxf(__uint_as_float(r[0]), __uint_as_float(r[1])); }
__device__ __forceinline__ float xsum16(float v) { auto r = __builtin_amdgcn_permlane16_swap(__float_as_uint(v), __float_as_uint(v), false, false); return __uint_as_float(r[0]) + __uint_as_float(r[1]); }
__device__ __forceinline__ float xsum32(float v) { auto r = __builtin_amdgcn_permlane32_swap(__float_as_uint(v), __float_as_uint(v), false, false); return __uint_as_float(r[0]) + __uint_as_float(r[1]); }
__device__ __forceinline__ float max3f(float a, float b, float c) { float r; asm("v_max3_f32 %0, %1, %2, %3" : "=v"(r) : "v"(a), "v"(b), "v"(c)); return r; }
__device__ __forceinline__ float max2f(float a, float b) { float r; asm("v_max_f32_e32 %0, %1, %2" : "=v"(r) : "v"(a), "v"(b)); return r; }
__device__ __forceinline__ float xmax16a(float v) { auto r = __builtin_amdgcn_permlane16_swap(__float_as_uint(v), __float_as_uint(v), false, false); return max2f(__uint_as_float(r[0]), __uint_as_float(r[1])); }
__device__ __forceinline__ float xmax32a(float v) { auto r = __builtin_amdgcn_permlane32_swap(__float_as_uint(v), __float_as_uint(v), false, false); return max2f(__uint_as_float(r[0]), __uint_as_float(r[1])); }
constexpr float ATT_THR = 8.0f;
constexpr int ATT_KP = 288, ATT_VP = 160, ATT_KB = 64 * ATT_KP, ATT_VB = 128 * ATT_VP, ATT_BUF = ATT_KB + ATT_VB;
#define SCHED_FENCE() __builtin_amdgcn_sched_barrier(0)
__device__ __forceinline__ void attn_vload(bf16x8 (&vf)[4], ldsp vb, int g, int r, int qq) {
#pragma unroll
    for (int i = 0; i < 4; ++i) { const int c = 2 * g + (i >> 1), u = i & 1;
        vf[i] = *(const LAS bf16x8*)(vb + (16 * c + r) * ATT_VP + (32 * u + 8 * qq) * 2); }
}
__device__ __forceinline__ void attn_tile(ldsp kb, int mapw, const bf16x8 (&qf)[2][2], f32x4 (&O)[2][8], f32x4 (&negm)[2], float (&lrun)[2], bool first, int r, int qq,
                                          const u32x4 (&KR)[2], const u32x4 (&VR)[2], ldsp kst, ldsp vst, bool do_store) {
    ldsp vb = kb + ATT_KB;
    bf16x8 pf[2][2];
    f32x4 s[2][4];
#pragma unroll
    for (int kt = 0; kt < 4; ++kt) {
        const bf16x8 k0 = *(const LAS bf16x8*)(kb + (16 * kt + r) * ATT_KP + (mapw * 64 + qq * 8) * 2);
        const bf16x8 k1 = *(const LAS bf16x8*)(kb + (16 * kt + r) * ATT_KP + (mapw * 64 + 32 + qq * 8) * 2);
#pragma unroll
        for (int mp = 0; mp < 2; ++mp) s[mp][kt] = mfma16(k1, qf[mp][1], mfma16(k0, qf[mp][0], negm[mp]));
    }
    asm volatile("s_nop 15" : "+v"(s[0][0]), "+v"(s[0][1]), "+v"(s[0][2]), "+v"(s[0][3]), "+v"(s[1][0]), "+v"(s[1][1]), "+v"(s[1][2]), "+v"(s[1][3]));
    bf16x8 vfa[4], vfb[4];
    attn_vload(vfa, vb, 0, r, qq);
    float mxl[2];
#pragma unroll
    for (int mp = 0; mp < 2; ++mp) {
        float mx = max3f(s[mp][0][0], s[mp][0][1], s[mp][0][2]);
        mx = max3f(mx, s[mp][0][3], s[mp][1][0]); mx = max3f(mx, s[mp][1][1], s[mp][1][2]); mx = max3f(mx, s[mp][1][3], s[mp][2][0]);
        mx = max3f(mx, s[mp][2][1], s[mp][2][2]); mx = max3f(mx, s[mp][2][3], s[mp][3][0]); mx = max3f(mx, s[mp][3][1], s[mp][3][2]); mxl[mp] = max2f(mx, s[mp][3][3]);
    }
    if (first || __any(max2f(mxl[0], mxl[1]) > ATT_THR)) {
#pragma unroll
        for (int mp = 0; mp < 2; ++mp) {
            const float mx = xmax32a(xmax16a(mxl[mp]));
            const float dl = first ? mx : fmaxf(mx, 0.f);
            const float al = __builtin_amdgcn_exp2f(-dl); lrun[mp] *= al;
            negm[mp] = negm[mp] - dl;
#pragma unroll
            for (int c = 0; c < 8; ++c) O[mp][c] = O[mp][c] * al;
#pragma unroll
            for (int kt = 0; kt < 4; ++kt) s[mp][kt] = s[mp][kt] - dl;
        }
    }
#pragma unroll
    for (int mp = 0; mp < 2; ++mp) {
        float ps = 0.f;
#pragma unroll
        for (int kt = 0; kt < 4; ++kt)
#pragma unroll
            for (int j = 0; j < 4; ++j) { s[mp][kt][j] = __builtin_amdgcn_exp2f(s[mp][kt][j]); ps += s[mp][kt][j]; }
        lrun[mp] += ps;
#pragma unroll
        for (int u = 0; u < 2; ++u) {
            u32x4 w; w.x = cvt_pk_bf16(s[mp][2 * u][0], s[mp][2 * u][1]); w.y = cvt_pk_bf16(s[mp][2 * u][2], s[mp][2 * u][3]);
            w.z = cvt_pk_bf16(s[mp][2 * u + 1][0], s[mp][2 * u + 1][1]); w.w = cvt_pk_bf16(s[mp][2 * u + 1][2], s[mp][2 * u + 1][3]);
            pf[mp][u] = __builtin_bit_cast(bf16x8, w);
        }
    }
    if (do_store) {
        *(LAS u32x4*)kst = KR[0]; *(LAS u32x4*)(kst + 32 * ATT_KP) = KR[1]; *(LAS u32x4*)vst = VR[0]; *(LAS u32x4*)(vst + 64 * ATT_VP) = VR[1]; }
#define ATT_PV(VF, g) do { _Pragma("unroll") for (int i = 0; i < 4; ++i) { const int c = 2 * (g) + (i >> 1), u = i & 1; \
        O[0][c] = mfma16(VF[i], pf[0][u], O[0][c]); O[1][c] = mfma16(VF[i], pf[1][u], O[1][c]); } } while (0)
    __builtin_amdgcn_s_setprio(1);
    SCHED_FENCE(); attn_vload(vfb, vb, 1, r, qq); SCHED_FENCE(); ATT_PV(vfa, 0);
    SCHED_FENCE(); attn_vload(vfa, vb, 2, r, qq); SCHED_FENCE(); ATT_PV(vfb, 1);
    SCHED_FENCE(); attn_vload(vfb, vb, 3, r, qq); SCHED_FENCE(); ATT_PV(vfa, 2);
    SCHED_FENCE(); ATT_PV(vfb, 3); SCHED_FENCE();
    __builtin_amdgcn_s_setprio(0);
#undef ATT_PV
}
__device__ __forceinline__ void attn_unit(ldsp lds, bf16_t* U, const bf16_t* TT, const float* hg, float lam, float post, int h, int qrow0, int seg0, int n0, int seg1, int n1) {
    int tid = threadIdx.x; asm volatile("" : "+v"(tid)); const int lane = tid & 63, wv = tid >> 6, r = lane & 15, qq = lane >> 4;
    bf16x8 qf[2][2];
    const int mapw = __builtin_amdgcn_readfirstlane(wv >> 2), wq = wv & 3;
#pragma unroll
    for (int mp = 0; mp < 2; ++mp)
#pragma unroll
        for (int ks = 0; ks < 2; ++ks) qf[mp][ks] = *(const bf16x8*)(U + (size_t)(qrow0 + 32 * wq + 16 * mp + r) * LDU + U_DAQ + h * 128 + mapw * 64 + ks * 32 + qq * 8);
    f32x4 O[2][8]; f32x4 negm[2]; float lrun[2];
#pragma unroll
    for (int mp = 0; mp < 2; ++mp) { negm[mp] = (f32x4){0.f, 0.f, 0.f, 0.f}; lrun[mp] = 0.f;
#pragma unroll
        for (int c = 0; c < 8; ++c) O[mp][c] = (f32x4){0.f, 0.f, 0.f, 0.f}; }
    const int NT = n0 + n1;
    u32x4 kA[2], vA[2], kB[2], vB[2];
    const int krow_l = tid >> 4, kcv = tid & 15, vrow_l = tid >> 3, vcv = tid & 7;
    const bf16_t* kbase = U + (size_t)krow_l * LDU + U_DAK + h * 128 + kcv * 8;
    const bf16_t* vbase = TT + (size_t)(1024 + h * 128 + vrow_l) * LDT + vcv * 8;
#define ATT_LOAD(t, KR, VR) do { const int kr0 = (t) < n0 ? seg0 + 64 * (t) : seg1 + 64 * ((t) - n0); \
        KR[0] = *(const u32x4*)(kbase + (size_t)kr0 * LDU); KR[1] = *(const u32x4*)(kbase + (size_t)(kr0 + 32) * LDU); \
        VR[0] = *(const u32x4*)(vbase + kr0); VR[1] = *(const u32x4*)(vbase + (size_t)64 * LDT + kr0); } while (0)
#define ATT_STORE(buf, KR, VR) do { ldsp kb_ = lds + (buf) * ATT_BUF; ldsp vb_ = kb_ + ATT_KB; \
        *(LAS u32x4*)(kb_ + krow_l * ATT_KP + kcv * 16) = KR[0]; *(LAS u32x4*)(kb_ + (krow_l + 32) * ATT_KP + kcv * 16) = KR[1]; \
        *(LAS u32x4*)(vb_ + vrow_l * ATT_VP + vcv * 16) = VR[0]; *(LAS u32x4*)(vb_ + (vrow_l + 64) * ATT_VP + vcv * 16) = VR[1]; } while (0)
    __syncthreads();
    ATT_LOAD(0, kA, vA); ATT_LOAD(1, kB, vB); ATT_STORE(0, kA, vA); __syncthreads();
#pragma unroll 1
    for (int t = 0; t < NT; t += 2) {
        if (t + 2 < NT) ATT_LOAD(t + 2, kA, vA);
        attn_tile(lds, mapw, qf, O, negm, lrun, t == 0, r, qq, kB, vB, lds + ATT_BUF + krow_l * ATT_KP + kcv * 16, lds + ATT_BUF + ATT_KB + vrow_l * ATT_VP + vcv * 16, true);
        __syncthreads();
        if (t + 3 < NT) ATT_LOAD(t + 3, kB, vB);
        attn_tile(lds + ATT_BUF, mapw, qf, O, negm, lrun, false, r, qq, kA, vA, lds + krow_l * ATT_KP + kcv * 16, lds + ATT_KB + vrow_l * ATT_VP + vcv * 16, t + 2 < NT);
        __syncthreads();
    }
#undef ATT_LOAD
#undef ATT_STORE
    {
        LAS f32x4* X = (LAS f32x4*)lds;
#pragma unroll
        for (int rg = 0; rg < 2; ++rg) {
            const float l = xsum32(xsum16(lrun[rg]));
            const float sc = (mapw ? lam : 1.0f) / l;
#pragma unroll
            for (int c = 0; c < 8; ++c) { O[rg][c] = O[rg][c] * sc; if (mapw) X[((wq * 2 + rg) * 8 + c) * 64 + lane] = O[rg][c]; }
        }
        __syncthreads();
        if (mapw == 0) {
#pragma unroll
            for (int rg = 0; rg < 2; ++rg) {
                float ss = 0.f;
#pragma unroll
                for (int c = 0; c < 8; ++c) { O[rg][c] = O[rg][c] - X[((wq * 2 + rg) * 8 + c) * 64 + lane]; ss += (O[rg][c][0] * O[rg][c][0] + O[rg][c][1] * O[rg][c][1]) + (O[rg][c][2] * O[rg][c][2] + O[rg][c][3] * O[rg][c][3]); }
                ss = xsum32(xsum16(ss));
                const float rn = post / sqrtf(ss * (1.0f / 128.0f) + EPS);
                bf16_t* orow = U + (size_t)(qrow0 + 32 * wq + 16 * rg + r) * LDU + U_DAQ + h * 128;
#pragma unroll
                for (int c = 0; c < 8; ++c) { const f32x4 gg = *(const f32x4*)(hg + h * 128 + 16 * c + 4 * qq); const f32x4 y = O[rg][c] * rn * gg;
                    u32x2 w; w.x = cvt_pk_bf16(y[0], y[1]); w.y = cvt_pk_bf16(y[2], y[3]); *(u32x2*)(orow + 16 * c + 4 * qq) = w; }
            }
        }
    }
}

__device__ __forceinline__ float logsigmoidf_(float x) { return fminf(x, 0.f) - __logf(1.0f + __expf(-fabsf(x))); }
__device__ __forceinline__ void gate_scan(const float* G, int row0, int icol, int fcol, int dir, float m, int lane, LAS float* tg, LAS float* tM, LAS float* tb, float& b_end, float& M_end) {
    const int p0 = dir ? 127 - 2 * lane : 2 * lane, p1 = dir ? p0 - 1 : p0 + 1;
    const float f0 = G[(size_t)(row0 + p0) * 16 + fcol], f1 = G[(size_t)(row0 + p1) * 16 + fcol];
    const float i0 = G[(size_t)(row0 + p0) * 16 + icol], i1 = G[(size_t)(row0 + p1) * 16 + icol];
    const float lf0 = logsigmoidf_(f0), lf1 = logsigmoidf_(f1);
    float inc = lf0 + lf1;
#pragma unroll
    for (int o = 1; o < 64; o <<= 1) { const float t = __shfl_up(inc, o); if (lane >= o) inc += t; }
    float exc = __shfl_up(inc, 1); if (lane == 0) exc = 0.f;
    const float b0 = exc + lf0, b1 = b0 + lf1;
    const float g0 = i0 - b0, g1 = i1 - b1;
    float cm = fmaxf(g0, g1);
#pragma unroll
    for (int o = 1; o < 64; o <<= 1) { const float t = __shfl_up(cm, o); if (lane >= o) cm = fmaxf(cm, t); }
    float exm = __shfl_up(cm, 1); if (lane == 0) exm = -1e30f;
    const float G0 = fmaxf(exm, g0), G1 = fmaxf(G0, g1);
    const float M0 = fmaxf(m, G0), M1 = fmaxf(m, G1);
    tg[p0] = g0; tg[p1] = g1; tM[p0] = M0; tM[p1] = M1; tb[p0] = b0; tb[p1] = b1;
    b_end = __shfl(b1, 63); M_end = __shfl(M1, 63);
}
__device__ __forceinline__ int chunk_row0(int b, int dir, int s) {
    if (s < 2) return ML_ROWS + b * CTXL + 128 * (dir ? 1 - s : s);
    return b * SEQ + 128 * (dir ? 33 - s : s - 2);
}
__device__ __forceinline__ void mlstm_state_unit(ldsp lds, const bf16_t* KT, const bf16_t* TT, const float* G, bf16_t* CT, float* NST, float* MST, int chain, int j) {
    int tid = threadIdx.x; asm volatile("" : "+v"(tid)); const int lane = tid & 63, wv = tid >> 6, r = lane & 15, qq = lane >> 4;
    const int dir = chain & 1, bh = chain >> 1, b = bh >> 2, h = bh & 3;
    const int dvq = j >> 1, dkh = j & 1, wa = wv >> 2, wb = wv & 3; const bool nown = (dvq == 0) && (wa == 0);
    const int dv0 = 64 * dvq + 32 * wa, dk0w = 128 * dkh + 32 * wb;
    LAS float* tgs = (LAS float*)lds; LAS float* tend = tgs + NCH * 128; LAS float* tdm = tend + 2 * NCH + 4;
    ldsp stg = (ldsp)(tdm + 8 * 256) + wv * (32 * 80);
    const int icol = (dir ? 8 : 0) + h, fcol = (dir ? 12 : 4) + h;
    __syncthreads();
    for (int s = wv; s < NCH; s += 8) { float be, Me; gate_scan(G, chunk_row0(b, dir, s), icol, fcol, dir, -1e30f, lane, tgs + s * 128, tdm + wv * 256, tdm + wv * 256 + 128, be, Me);
        if (lane == 0) { tend[2 * s] = Me; tend[2 * s + 1] = be; } }
    __syncthreads();
    f32x4 acc[2][2];
#pragma unroll
    for (int a = 0; a < 2; ++a)
#pragma unroll
        for (int e = 0; e < 2; ++e) acc[a][e] = (f32x4){0.f, 0.f, 0.f, 0.f};
    float nval[2] = {0.f, 0.f}, m = 0.f;
    bf16x8 k0[2][2], v0[2][2], k1[2][2], v1[2][2], k2[2][2], v2[2][2], k3[2][2], v3[2][2];
    const bf16_t* kbase = KT + (size_t)(h * 256 + dk0w + r) * LDT + 8 * qq;
    const bf16_t* vbase = TT + (size_t)(h * 256 + dv0 + r) * LDT + 8 * qq;
#define M1_LOAD(KR, VR, s_, hf) do { const int row0_ = chunk_row0(b, dir, (s_)) + 64 * (hf); \
        _Pragma("unroll") for (int e = 0; e < 2; ++e) _Pragma("unroll") for (int ks = 0; ks < 2; ++ks) { \
            KR[e][ks] = *(const bf16x8*)(kbase + (size_t)(16 * e) * LDT + row0_ + 32 * ks); VR[e][ks] = *(const bf16x8*)(vbase + (size_t)(16 * e) * LDT + row0_ + 32 * ks); } } while (0)
    float Mend_ = 0.f, decay_ = 1.f, bend_ = 0.f, ns0_ = 0.f, ns1_ = 0.f;
#define M1_BEGIN(s_) do { \
        { _Pragma("unroll") for (int a = 0; a < 2; ++a) _Pragma("unroll") for (int e = 0; e < 2; ++e) _Pragma("unroll") for (int jj = 0; jj < 4; ++jj) \
              *(LAS bf16_t*)(stg + (16 * a + 4 * qq + jj) * 80 + (16 * e + r) * 2) = (bf16_t)(cvt_pk_bf16(acc[a][e][jj], 0.f) & 0xffffu); \
          if (nown) { if (qq == 0) { NST[(size_t)(chain * NCH + (s_)) * 256 + dk0w + r] = nval[0]; NST[(size_t)(chain * NCH + (s_)) * 256 + dk0w + 16 + r] = nval[1]; } if (j == 0 && tid == 0) MST[chain * NCH + (s_)] = m; } \
          asm volatile("s_waitcnt lgkmcnt(0)" ::: "memory"); \
          bf16_t* ct = CT + ((size_t)(chain * NCH + (s_))) * 65536 + (size_t)dv0 * 256 + dk0w; \
          _Pragma("unroll") for (int i = 0; i < 2; ++i) { const int pc_ = lane + 64 * i, row_ = pc_ >> 2, cv_ = pc_ & 3; \
              *(u32x4*)(ct + (size_t)row_ * 256 + cv_ * 8) = *(const LAS u32x4*)(stg + row_ * 80 + cv_ * 16); } } \
        const float Gend_ = tend[2 * (s_)]; bend_ = tend[2 * (s_) + 1]; Mend_ = fmaxf(m, Gend_); decay_ = __expf(m - Mend_); \
        _Pragma("unroll") for (int a = 0; a < 2; ++a) _Pragma("unroll") for (int e = 0; e < 2; ++e) acc[a][e] = acc[a][e] * decay_; \
        ns0_ = 0.f; ns1_ = 0.f; } while (0)
#define M1_HALF(KR, VR, s_, hf) do { \
        _Pragma("unroll") for (int ks = 0; ks < 2; ++ks) { \
            const f32x4 g0_ = *(const LAS f32x4*)(tgs + (s_) * 128 + 64 * (hf) + 32 * ks + 8 * qq), g1_ = *(const LAS f32x4*)(tgs + (s_) * 128 + 64 * (hf) + 32 * ks + 8 * qq + 4); \
            float w_[8]; _Pragma("unroll") for (int i = 0; i < 4; ++i) { w_[i] = __expf(g0_[i] - Mend_); w_[4 + i] = __expf(g1_[i] - Mend_); } \
            bf16x8 vw_[2]; \
            _Pragma("unroll") for (int a = 0; a < 2; ++a) { const u32x4 x_ = __builtin_bit_cast(u32x4, VR[a][ks]); const unsigned xs_[4] = {x_.x, x_.y, x_.z, x_.w}; u32x4 o_; unsigned os_[4]; \
                _Pragma("unroll") for (int i = 0; i < 4; ++i) os_[i] = cvt_pk_bf16(__uint_as_float(xs_[i] << 16) * w_[2 * i], __uint_as_float(xs_[i] & 0xffff0000u) * w_[2 * i + 1]); \
                o_.x = os_[0]; o_.y = os_[1]; o_.z = os_[2]; o_.w = os_[3]; vw_[a] = __builtin_bit_cast(bf16x8, o_); } \
            if (nown) { _Pragma("unroll") for (int e = 0; e < 2; ++e) { const u32x4 x_ = __builtin_bit_cast(u32x4, KR[e][ks]); const unsigned xs_[4] = {x_.x, x_.y, x_.z, x_.w}; float t_ = 0.f; \
                _Pragma("unroll") for (int i = 0; i < 4; ++i) t_ += __uint_as_float(xs_[i] << 16) * w_[2 * i] + __uint_as_float(xs_[i] & 0xffff0000u) * w_[2 * i + 1]; \
                if (e == 0) ns0_ += t_; else ns1_ += t_; } } \
            _Pragma("unroll") for (int e = 0; e < 2; ++e) _Pragma("unroll") for (int a = 0; a < 2; ++a) acc[a][e] = mfma16(vw_[a], KR[e][ks], acc[a][e]); } } while (0)
#define M1_END() do { \
        if (nown) { nval[0] = decay_ * nval[0] + xsum32(xsum16(ns0_)); nval[1] = decay_ * nval[1] + xsum32(xsum16(ns1_)); } \
        m = bend_ + Mend_; } while (0)
    M1_LOAD(k0, v0, 0, 0); M1_LOAD(k1, v1, 0, 1); M1_LOAD(k2, v2, 1, 0); M1_LOAD(k3, v3, 1, 1);
#pragma unroll 1
    for (int s = 0; s < NCH; s += 2) {
        M1_BEGIN(s);
        M1_HALF(k0, v0, s, 0); if (s + 2 < NCH) M1_LOAD(k0, v0, s + 2, 0);
        M1_HALF(k1, v1, s, 1); if (s + 2 < NCH) M1_LOAD(k1, v1, s + 2, 1);
        M1_END();
        M1_BEGIN(s + 1);
        M1_HALF(k2, v2, s + 1, 0); if (s + 3 < NCH) M1_LOAD(k2, v2, s + 3, 0);
        M1_HALF(k3, v3, s + 1, 1); if (s + 3 < NCH) M1_LOAD(k3, v3, s + 3, 1);
        M1_END();
    }
#undef M1_BEGIN
#undef M1_HALF
#undef M1_END
#undef M1_LOAD
}
__device__ __forceinline__ void mlstm_out_unit(ldsp lds, bf16_t* U, const bf16_t* TT, const float* G, const bf16_t* CT, const float* NST, const float* MST, const float* hg, int b, int h, int loc) {
    int tid = threadIdx.x; asm volatile("" : "+v"(tid)); const int lane = tid & 63, wv = tid >> 6, r = lane & 15, qq = lane >> 4;
    constexpr int QP = 544, PP = 288, QS = 0, KS = 128 * QP, TB = 2 * 128 * QP;
    LAS float* tgF = (LAS float*)(lds + TB); LAS float* tMF = tgF + 128; LAS float* tbF = tgF + 256;
    LAS float* tgB = tgF + 384; LAS float* tMB = tgF + 512; LAS float* tbB = tgF + 640;
    LAS float* tcf = tgF + 768; LAS float* tcb = tgF + 896; LAS float* tss = tgF + 1024;
    const int row0 = loc < 2 ? ML_ROWS + b * CTXL + 128 * loc : b * SEQ + 128 * (loc - 2);
    const int sF = loc, sB = loc < 2 ? 1 - loc : 35 - loc;
    const int chF = ((b * 4 + h) * 2), chB = chF + 1;
    const float mF = MST[chF * NCH + sF], mB = MST[chB * NCH + sB];
    __syncthreads();
#pragma unroll
    for (int i = 0; i < 8; ++i) { const int v = tid + 512 * i, row = v >> 5, cv = v & 31;
        *(LAS u32x4*)(lds + QS + row * QP + cv * 16) = *(const u32x4*)(U + (size_t)(row0 + row) * LDU + U_MLQ + h * 256 + cv * 8);
        *(LAS u32x4*)(lds + KS + row * QP + cv * 16) = *(const u32x4*)(U + (size_t)(row0 + row) * LDU + U_MLK + h * 256 + cv * 8); }
    LAS bf16_t* tn = (LAS bf16_t*)(tss + 1024);
    if (wv == 2) { const int d = lane >> 5, pc = lane & 31; const float* np = NST + (size_t)(d ? chB * NCH + sB : chF * NCH + sF) * 256 + 8 * pc;
        *(LAS u32x4*)(tn + d * 256 + 8 * pc) = pack8(*(const f32x4*)np, *(const f32x4*)(np + 4)); }
    if (wv == 0) { float be, Me; gate_scan(G, row0, h, 4 + h, 0, mF, lane, tgF, tMF, tbF, be, Me); }
    if (wv == 1) { float be, Me; gate_scan(G, row0, 8 + h, 12 + h, 1, mB, lane, tgB, tMB, tbB, be, Me); }
    __syncthreads();
    {
        const int p = 16 * wv + r;
        f32x4 S[8], Sn = (f32x4){0.f, 0.f, 0.f, 0.f};
#pragma unroll
        for (int ct = 0; ct < 8; ++ct) S[ct] = (f32x4){0.f, 0.f, 0.f, 0.f};
#pragma unroll 2
        for (int ks = 0; ks < 8; ++ks) {
            const bf16x8 qv = *(const LAS bf16x8*)(lds + QS + p * QP + (32 * ks + 8 * qq) * 2);
#pragma unroll
            for (int ct = 0; ct < 8; ++ct) S[ct] = mfma16(*(const LAS bf16x8*)(lds + KS + (16 * ct + r) * QP + (32 * ks + 8 * qq) * 2), qv, S[ct]);
            u32x4 w = *(const LAS u32x4*)(tn + (r & 1) * 256 + 32 * ks + 8 * qq);
            if (r >= 2) w = (u32x4){0u, 0u, 0u, 0u};
            Sn = mfma16(__builtin_bit_cast(bf16x8, w), qv, Sn);
        }
        const float qnF = __shfl(Sn[0], r), qnB = __shfl(Sn[1], r);
        const float MFp = tMF[p], MBp = tMB[p];
        float sumF = 0.f, sumB = 0.f;
#pragma unroll
        for (int ct = 0; ct < 8; ++ct)
#pragma unroll
            for (int jj = 0; jj < 4; ++jj) { const int sg = 16 * ct + 4 * qq + jj;
                const float ef = sg <= p ? __expf(tgF[sg] - MFp) : 0.f, eb = sg >= p ? __expf(tgB[sg] - MBp) : 0.f;
                sumF += ef * S[ct][jj]; sumB += eb * S[ct][jj]; }
        sumF += __shfl_xor(sumF, 16); sumF += __shfl_xor(sumF, 32); sumB += __shfl_xor(sumB, 16); sumB += __shfl_xor(sumB, 32);
        const float scF = __expf(mF - MFp), scB = __expf(mB - MBp);
        const float denF = scF * qnF + sumF, denB = scB * qnB + sumB;
        const float rF = 1.0f / fmaxf(fabsf(denF), __expf(-(tbF[p] + MFp))), rB = 1.0f / fmaxf(fabsf(denB), __expf(-(tbB[p] + MBp)));
        if (qq == 0) { tcf[p] = scF * rF; tcb[p] = scB * rB; }
#pragma unroll
        for (int ct = 0; ct < 8; ++ct)
#pragma unroll
            for (int jj = 0; jj < 4; ++jj) { const int sg = 16 * ct + 4 * qq + jj;
                const float ef = sg <= p ? __expf(tgF[sg] - MFp) : 0.f, eb = sg >= p ? __expf(tgB[sg] - MBp) : 0.f;
                S[ct][jj] *= (ef * rF + eb * rB); }
        __syncthreads();
#pragma unroll
        for (int ct = 0; ct < 8; ++ct) {
            u32x2 w; w.x = cvt_pk_bf16(S[ct][0], S[ct][1]); w.y = cvt_pk_bf16(S[ct][2], S[ct][3]);
            *(LAS u32x2*)(lds + KS + p * PP + (16 * ct + 4 * qq) * 2) = w; }
    }
    __syncthreads();
    f32x4 O[2][8];
#pragma unroll
    for (int a = 0; a < 2; ++a)
#pragma unroll
        for (int tt = 0; tt < 8; ++tt) O[a][tt] = (f32x4){0.f, 0.f, 0.f, 0.f};
    bf16x8 cfA[8], cfB[8];
#define M2_CF(CF, pass_) do { const bf16_t* ct_ = CT + (size_t)(((pass_) & 1) ? chB * NCH + sB : chF * NCH + sF) * 65536 + (size_t)(32 * wv + 16 * ((pass_) >> 1) + r) * 256 + 8 * qq; \
        _Pragma("unroll") for (int ks = 0; ks < 8; ++ks) CF[ks] = *(const bf16x8*)(ct_ + 32 * ks); } while (0)
#define M2_PASS(CF, pass_) do { f32x4 T[8]; \
        _Pragma("unroll") for (int tt = 0; tt < 8; ++tt) T[tt] = (f32x4){0.f, 0.f, 0.f, 0.f}; \
        _Pragma("unroll") for (int ks = 0; ks < 8; ++ks) { \
            _Pragma("unroll") for (int tt = 0; tt < 8; ++tt) T[tt] = mfma16(CF[ks], *(const LAS bf16x8*)(lds + QS + (16 * tt + r) * QP + (32 * ks + 8 * qq) * 2), T[tt]); \
            SCHED_FENCE(); } \
        LAS float* tc_ = ((pass_) & 1) ? tcb : tcf; \
        _Pragma("unroll") for (int tt = 0; tt < 8; ++tt) O[(pass_) >> 1][tt] = O[(pass_) >> 1][tt] + T[tt] * tc_[16 * tt + r]; } while (0)
    bf16x8 vf[2][4];
    M2_CF(cfA, 0);
    M2_CF(cfB, 1); M2_PASS(cfA, 0);
    M2_CF(cfA, 2); M2_PASS(cfB, 1);
    M2_CF(cfB, 3); M2_PASS(cfA, 2);
#pragma unroll
    for (int a = 0; a < 2; ++a)
#pragma unroll
        for (int u = 0; u < 4; ++u) vf[a][u] = *(const bf16x8*)(TT + (size_t)(h * 256 + 32 * wv + 16 * a + r) * LDT + row0 + 32 * u + 8 * qq);
    M2_PASS(cfB, 3);
#undef M2_CF
#undef M2_PASS
    {
#pragma unroll
        for (int u = 0; u < 4; ++u) {
#pragma unroll
            for (int tt = 0; tt < 8; ++tt) { const bf16x8 pv = *(const LAS bf16x8*)(lds + KS + (16 * tt + r) * PP + (32 * u + 8 * qq) * 2);
                O[0][tt] = mfma16(vf[0][u], pv, O[0][tt]); O[1][tt] = mfma16(vf[1][u], pv, O[1][tt]); }
            SCHED_FENCE();
        }
    }
#pragma unroll
    for (int tt = 0; tt < 8; ++tt) { float ss = 0.f;
#pragma unroll
        for (int a = 0; a < 2; ++a) ss += (O[a][tt][0] * O[a][tt][0] + O[a][tt][1] * O[a][tt][1]) + (O[a][tt][2] * O[a][tt][2] + O[a][tt][3] * O[a][tt][3]);
        ss += __shfl_xor(ss, 16); ss += __shfl_xor(ss, 32);
        if (qq == 0) tss[wv * 128 + 16 * tt + r] = ss; }
    __syncthreads();
#pragma unroll
    for (int tt = 0; tt < 8; ++tt) { const int p = 16 * tt + r; float ss = 0.f;
#pragma unroll
        for (int w = 0; w < 8; ++w) ss += tss[w * 128 + p];
        const float rn = 1.0f / sqrtf(ss * (1.0f / 256.0f) + EPS);
#pragma unroll
        for (int a = 0; a < 2; ++a) { const int dv = 32 * wv + 16 * a + 4 * qq;
            bf16_t* op = U + (size_t)(row0 + p) * LDU + U_OG + h * 256 + dv;
            const u32x2 gw = *(const u32x2*)op; const f32x4 gg = *(const f32x4*)(hg + h * 256 + dv);
            f32x4 y = O[a][tt] * rn * gg;
            y[0] *= __uint_as_float(gw.x << 16); y[1] *= __uint_as_float(gw.x & 0xffff0000u); y[2] *= __uint_as_float(gw.y << 16); y[3] *= __uint_as_float(gw.y & 0xffff0000u);
            u32x2 w; w.x = cvt_pk_bf16(y[0], y[1]); w.y = cvt_pk_bf16(y[2], y[3]); *(u32x2*)op = w; }
    }
}


#define XB_TMO      128
#define XB_XCNT(j)  (256  + 64 * (j))
#define XB_XSUB(j)  (1280 + 64 * (j))
#define XB_XGEN(j)  (2304 + 64 * (j))
#define XB_TOP      3328
#define XB_TOPGEN   3392
#define XCD_BAR_WORDS 3456
#define XB_SPIN_CAP (1u << 18)
__device__ __forceinline__ unsigned xb_ld(unsigned* p)              { return __hip_atomic_load(p, __ATOMIC_RELAXED, __HIP_MEMORY_SCOPE_AGENT); }
__device__ __forceinline__ unsigned xb_add(unsigned* p, unsigned v) { return __hip_atomic_fetch_add(p, v, __ATOMIC_RELAXED, __HIP_MEMORY_SCOPE_AGENT); }
__device__ __forceinline__ unsigned xb_xcc_id() { return (unsigned)__builtin_amdgcn_s_getreg((3 << 11) | 20) & 0xFu; }
#define XB_SPIN(cond, bar) do { unsigned _sp = 0; while (cond) { __builtin_amdgcn_s_sleep(1); \
    if ((++_sp & 255u) == 0u) { if (xb_ld(&(bar)[XB_TMO])) break; if (_sp > XB_SPIN_CAP) { atomicAdd(&(bar)[XB_TMO], 1u); break; } } } } while (0)
struct XcdBarrier { unsigned* bar; unsigned x; volatile LAS unsigned* st; };
__device__ __forceinline__ XcdBarrier xcd_barrier_post(unsigned* bar, volatile LAS unsigned* st) {
    XcdBarrier b; b.bar = bar; b.x = xb_xcc_id(); b.st = st;
    if (threadIdx.x == 0) (void)xb_add(&bar[XB_XCNT(b.x)], 1u);
    return b;
}
__device__ __forceinline__ void xcd_barrier_complete(unsigned* bar, unsigned x, unsigned& nloc, unsigned& nx) {
    const unsigned G = gridDim.x * gridDim.y * gridDim.z;
    unsigned sum, cnt, mine, sp = 0u;
    for (;;) {
        sum = 0u; cnt = 0u; mine = 0u;
#pragma unroll
        for (unsigned j = 0; j < 16; ++j) { const unsigned c = xb_ld(&bar[XB_XCNT(j)]); sum += c; cnt += (c > 0u) ? 1u : 0u; mine = (j == x) ? c : mine; }
        if (sum == G) break;
        __builtin_amdgcn_s_sleep(1);
        if ((++sp & 255u) == 0u) { if (xb_ld(&bar[XB_TMO])) break; if (sp > XB_SPIN_CAP) { atomicAdd(&bar[XB_TMO], 1u); break; } }
    }
    nloc = mine > 0u ? mine : 1u; nx = cnt > 0u ? cnt : 1u;
}
__device__ __forceinline__ void xcd_barrier(const XcdBarrier& b) {
    asm volatile("s_waitcnt vmcnt(0)" ::: "memory");
    __syncthreads();
    if (threadIdx.x == 0) {
        unsigned* bar = b.bar;
        __builtin_amdgcn_s_waitcnt(0);
        unsigned nloc = b.st[0], nx = b.st[1];
        if (nloc == 0u) { xcd_barrier_complete(bar, b.x, nloc, nx); b.st[0] = nloc; b.st[1] = nx; }
        const unsigned old = xb_add(&bar[XB_XSUB(b.x)], 1u);
        const unsigned gen = old / nloc;
        if (old + 1u == (gen + 1u) * nloc) {
            __builtin_amdgcn_fence(__ATOMIC_RELEASE, "agent");
            asm volatile("s_waitcnt vmcnt(0)" ::: "memory");
            const unsigned og = xb_add(&bar[XB_TOP], 1u);
            const unsigned tg = og / nx;
            if (og + 1u == (tg + 1u) * nx) xb_add(&bar[XB_TOPGEN], 1u);
            else XB_SPIN(xb_ld(&bar[XB_TOPGEN]) == tg, bar);
            __builtin_amdgcn_fence(__ATOMIC_ACQUIRE, "agent");
            xb_add(&bar[XB_XGEN(b.x)], 1u);
            asm volatile("s_waitcnt vmcnt(0)" ::: "memory");
        } else {
            XB_SPIN(xb_ld(&bar[XB_XGEN(b.x)]) == gen, bar);
            __builtin_amdgcn_fence(__ATOMIC_ACQUIRE, "agent");
            asm volatile("s_waitcnt vmcnt(0)" ::: "memory");
        }
    }
    __syncthreads();
}

struct Params {
    const float *x, *c, *ctx, *c_ctx, *w_ada, *b_ada, *norm_g, *w_in, *ml_gate_b, *ml_head_g, *da_lam, *da_head_g, *w_br_ml, *w_br_da, *w_br_fn, *w_out, *w_ffn_in, *w_ffn_out, *final_g;
    float* out; unsigned char* ws;
};

struct WSeg { const float* W; int ldn, off, width, K; bf16_t* dst; int Kd, row_off, perm, nitems; };
__device__ __forceinline__ WSeg wseg(const Params& P, int l, int s) {
    WSeg g; unsigned char* ws = P.ws;
    const float* win = P.w_in + (size_t)l * DM * DIN; bf16_t* WIN = (bf16_t*)(ws + WS_WIN);
    g.ldn = DIN; g.K = DM; g.Kd = DM; g.perm = 0; g.width = 1024; g.W = win; g.dst = WIN; g.off = 0; g.row_off = 0;
    switch (s) {
        case 0: g.off = 0;    g.row_off = 7424; break;
        case 1: g.off = 1024; g.row_off = 8448; break;
        case 2: g.off = 2048; g.row_off = 9472; break;
        case 3: g.off = 3072; g.row_off = 6400; break;
        case 4: g.off = 4096; g.row_off = 0; g.width = 16; break;
        case 5: g.off = 4112; g.row_off = 5376; g.perm = 1; break;
        case 6: g.off = 5136; g.row_off = 4352; g.perm = 1; break;
        case 7: g.off = 6160; g.row_off = 10496; break;
        case 8: g.off = 7184; g.row_off = 3328; break;
        case 9: g.off = 8208; g.row_off = 256; g.width = 3072; break;
        case 10: g.W = P.w_br_ml + (size_t)l * DM * DM; g.ldn = DM; g.dst = (bf16_t*)(ws + WS_WBR); break;
        case 11: g.W = P.w_br_da + (size_t)l * DM * DM; g.ldn = DM; g.dst = (bf16_t*)(ws + WS_WBR) + (size_t)DM * DM; break;
        case 12: g.W = P.w_br_fn + (size_t)l * DM * DM; g.ldn = DM; g.dst = (bf16_t*)(ws + WS_WBR) + (size_t)2 * DM * DM; break;
        case 13: g.W = P.w_out + (size_t)l * DM * DM; g.ldn = DM; g.dst = (bf16_t*)(ws + WS_WOUT); break;
        case 14: g.W = P.w_ffn_in + (size_t)l * DM * 2 * DFF; g.ldn = 2 * DFF; g.width = 2 * DFF; g.dst = (bf16_t*)(ws + WS_WF1); g.perm = 2; break;
        default: g.W = P.w_ffn_out + (size_t)l * DFF * DM; g.ldn = DM; g.K = DFF; g.Kd = DFF; g.dst = (bf16_t*)(ws + WS_WF2); break;
    }
    g.nitems = (g.K / 64) * ((g.width + 31) / 32);
    return g;
}


__device__ __forceinline__ void convert_dynamic(const Params& P, ldsp lds, int lw, int s_lo, int s_hi, unsigned* ctr, int max_grabs = 1 << 30) {
    int tid = threadIdx.x; asm volatile("" : "+v"(tid)); const int lane = tid & 63, wv = tid >> 6;
    LAS float* scr = (LAS float*)(lds + wv * 8448); LAS unsigned* slot = (LAS unsigned*)(lds + 8 * 8448);
    int total = 0;
    for (int sg = s_lo; sg < s_hi; ++sg) total += wseg(P, lw, sg).nitems;
    __syncthreads();
    for (int gcount = 0; gcount < max_grabs; ++gcount) {
        if (tid == 0) *slot = atomicAdd(ctr, 8u);
        __syncthreads();
        const int base = (int)*slot;
        __syncthreads();
        if (base >= total) break;
        int it = base + wv;
        if (it < total) {
            int sg = s_lo; WSeg g = wseg(P, lw, sg);
            while (it >= g.nitems) { it -= g.nitems; ++sg; g = wseg(P, lw, sg); }
            const int nbk = (g.width + 31) / 32;
            transpose_item(g.W, g.ldn, g.off, g.width, g.dst, g.Kd, g.row_off, g.perm, scr, it / nbk, it % nbk, lane);
        }
    }
}

__global__ void __launch_bounds__(512, 2) fwd_megakernel(Params P) {
    extern __shared__ __attribute__((aligned(16))) unsigned char lds_raw[];
    cg::grid_group grid = cg::this_grid();
    ldsp lds = (ldsp)lds_raw;
    int tid = threadIdx.x; asm volatile("" : "+v"(tid)); const int G = gridDim.x, bx = blockIdx.x;
    const int vcu = (G % 8 == 0) ? (bx % 8) * (G / 8) + bx / 8 : bx;
    const int NGW = G * 8;
    const int gt = bx * 512 + tid, NGT = G * 512;
    volatile LAS unsigned* xst = (volatile LAS unsigned*)(lds + LDS_BYTES - 16);
    if (threadIdx.x < 4) xst[threadIdx.x] = 0u;
    __syncthreads();
    const XcdBarrier xbar = xcd_barrier_post((unsigned*)(P.ws + WS_BAR), xst);
    {
    unsigned char* ws = P.ws; asm volatile("" : "+s"(ws));
    bf16_t* U = (bf16_t*)(ws + WS_U); bf16_t* TT = (bf16_t*)(ws + WS_TT); float* XC = (float*)(ws + WS_XC); bf16_t* AB = (bf16_t*)(ws + WS_AB);
    bf16_t* AT = (bf16_t*)(ws + WS_AB); bf16_t* KT = (bf16_t*)(ws + WS_KT); bf16_t* ATC = (bf16_t*)(ws + WS_ATC); bf16_t* Dm = (bf16_t*)(ws + WS_D); bf16_t* Dc = (bf16_t*)(ws + WS_DC); bf16_t* Wc = (bf16_t*)(ws + WS_WC);
    float* ROPE = (float*)(ws + WS_ROPE); float* MODS = (float*)(ws + WS_MODS); float* GG = (float*)(ws + WS_G); float* NST = (float*)(ws + WS_NST); float* MST = (float*)(ws + WS_MST);
    unsigned* CTR = (unsigned*)(ws + WS_CTR); bf16_t* CT = (bf16_t*)(ws + WS_CT); float* Y = (float*)(ws + WS_CT); float* YC = (float*)(ws + WS_CT + 72 * MiB); float* TP6 = (float*)(ws + WS_CT); float* TP9 = (float*)(ws + WS_CT + 4 * MiB); bf16_t* HID = (bf16_t*)(ws + WS_U);
    bf16_t* WIN = (bf16_t*)(ws + WS_WIN); bf16_t* WBR = (bf16_t*)(ws + WS_WBR); bf16_t* WOUT = (bf16_t*)(ws + WS_WOUT); bf16_t* WF1 = (bf16_t*)(ws + WS_WF1); bf16_t* WF2 = (bf16_t*)(ws + WS_WF2);

        for (int v = gt; v < 4096 * 512; v += NGT) { const int tp = v >> 9, k0 = (v & 511) * 8; float e[8];
#pragma unroll
            for (int j = 0; j < 8; ++j) { const int k = k0 + j; const float a = (float)((k * tp) & 4095) * (1.0f / 2048.0f); e[j] = (k <= 2048 ? cospif(a) : -sinpif(a)) * (1.0f / 64.0f); }
            u32x4 w; w.x = cvt_pk_bf16(e[0], e[1]); w.y = cvt_pk_bf16(e[2], e[3]); w.z = cvt_pk_bf16(e[4], e[5]); w.w = cvt_pk_bf16(e[6], e[7]);
            *(u32x4*)(Dm + (size_t)tp * 4096 + k0) = w; }
        for (int v = gt; v < 256 * 512; v += NGT) {
            { const int tp = v >> 9, k = v & 511, ri = k >> 8, t = k & 255; const float a = (float)((t * tp) & 255) * (1.0f / 128.0f);
              Dc[v] = (bf16_t)(cvt_pk_bf16((ri ? sinpif(a) : cospif(a)) * (1.0f / 16.0f), 0.f) & 0xffffu); }
            { const int row = v >> 8, c = v & 255, ri = row >> 8, cp = row & 255; const float a = (float)((c * cp) & 255) * (1.0f / 128.0f);
              Wc[v] = (bf16_t)(cvt_pk_bf16((ri ? -sinpif(a) : cospif(a)) * (1.0f / 16.0f), 0.f) & 0xffffu); }
        }
        for (int v = gt; v < 4096 * 32; v += NGT) { const int t = v >> 5, i = v & 31; const float pos = (float)(i < 16 ? (t >> 6) : (t & 63));
            const float inv = powf(10000.0f, -(float)(i & 15) * (1.0f / 16.0f)); const float ang = pos * inv; ROPE[2 * v] = cosf(ang); ROPE[2 * v + 1] = sinf(ang); }
        LAS float* sl = (LAS float*)lds; LAS float* red = sl + 5 * 1024;
        for (int i = tid; i < 5 * 1024; i += 512) { const float cvv = i < 4096 ? P.c[i] : P.c_ctx[i - 4096]; sl[i] = cvv * sigmoidf_(cvv); }
        __syncthreads();
        for (int it = bx; it < DEPTH * 192; it += G) {
            const int l = it / 192, n0 = (it % 192) * 32, col = tid & 31, ksg = tid >> 5;
            const float* W = P.w_ada + (size_t)l * DM * 6144 + n0 + col;
            float a[5] = {0.f, 0.f, 0.f, 0.f, 0.f};
#pragma unroll 8
            for (int kk = 0; kk < 64; ++kk) { const int k = ksg * 64 + kk; const float w = W[(size_t)k * 6144];
#pragma unroll
                for (int s = 0; s < 5; ++s) a[s] += sl[s * 1024 + k] * w; }
#pragma unroll
            for (int s = 0; s < 5; ++s) red[(ksg * 5 + s) * 32 + col] = a[s];
            __syncthreads();
            if (tid < 160) { const int s = tid >> 5, cc = tid & 31; float sum = 0.f;
#pragma unroll
                for (int q = 0; q < 16; ++q) sum += red[(q * 5 + s) * 32 + cc];
                MODS[(size_t)(l * 5 + s) * 6144 + n0 + cc] = sum + P.b_ada[(size_t)l * 6144 + n0 + cc]; }
            __syncthreads();
        }
    }
    grid.sync();

#pragma unroll 1
    for (int l = 0; l < DEPTH; ++l) {
        int tidl = threadIdx.x; asm volatile("" : "+v"(tidl));
        const int lane = tidl & 63, wv = tidl >> 6, gw = bx * 8 + wv;
    unsigned char* ws = P.ws; asm volatile("" : "+s"(ws));
    bf16_t* U = (bf16_t*)(ws + WS_U); bf16_t* TT = (bf16_t*)(ws + WS_TT); float* XC = (float*)(ws + WS_XC); bf16_t* AB = (bf16_t*)(ws + WS_AB);
    bf16_t* AT = (bf16_t*)(ws + WS_AB); bf16_t* KT = (bf16_t*)(ws + WS_KT); bf16_t* ATC = (bf16_t*)(ws + WS_ATC); bf16_t* Dm = (bf16_t*)(ws + WS_D); bf16_t* Dc = (bf16_t*)(ws + WS_DC); bf16_t* Wc = (bf16_t*)(ws + WS_WC);
    float* ROPE = (float*)(ws + WS_ROPE); float* MODS = (float*)(ws + WS_MODS); float* GG = (float*)(ws + WS_G); float* NST = (float*)(ws + WS_NST); float* MST = (float*)(ws + WS_MST);
    unsigned* CTR = (unsigned*)(ws + WS_CTR); bf16_t* CT = (bf16_t*)(ws + WS_CT); float* Y = (float*)(ws + WS_CT); float* YC = (float*)(ws + WS_CT + 72 * MiB); float* TP6 = (float*)(ws + WS_CT); float* TP9 = (float*)(ws + WS_CT + 4 * MiB); bf16_t* HID = (bf16_t*)(ws + WS_U);
    bf16_t* WIN = (bf16_t*)(ws + WS_WIN); bf16_t* WBR = (bf16_t*)(ws + WS_WBR); bf16_t* WOUT = (bf16_t*)(ws + WS_WOUT); bf16_t* WF1 = (bf16_t*)(ws + WS_WF1); bf16_t* WF2 = (bf16_t*)(ws + WS_WF2);

        const bool need_ctx = l < DEPTH - 1;
        const float lam_init = 0.8f - 0.6f * expf(-0.3f * (float)l);
        const float* srcL = l == 0 ? P.x : P.out; const float* srcC = l == 0 ? P.ctx : XC;
        const float* mods = MODS + (size_t)l * 5 * 6144;
        const int nMr = need_ctx ? 68 : 64;
        {
            LAS float* scr = (LAS float*)(lds + wv * 8448);
            int base = 0;
            for (int s = (l == 0 ? 0 : 15); s < 16; ++s) { const WSeg g = wseg(P, l, s); const int nbk = (g.width + 31) / 32;
                int it = gw - (base % NGW); if (it < 0) it += NGW;
                for (; it < g.nitems; it += NGW) transpose_item(g.W, g.ldn, g.off, g.width, g.dst, g.Kd, g.row_off, g.perm, scr, it / nbk, it % nbk, lane);
                base += g.nitems; }
            for (int row = gw; row < MROWS; row += NGW) { const bool lat = row < ML_ROWS; const int s = lat ? row >> 12 : 4;
                const float* xr = lat ? srcL + (size_t)row * DM : srcC + (size_t)(row - ML_ROWS) * DM;
                if (lat || l == 0) norm_mod_row(xr, P.norm_g + (size_t)(l * 2) * DM, mods + s * 6144, mods + s * 6144 + 1024, AB + (size_t)row * DM, lane);
                else norm_mod_row(xr, P.norm_g + (size_t)(l * 2) * DM, mods + s * 6144, mods + s * 6144 + 1024, AB + (size_t)row * DM, lane, TP9 + (size_t)(row - ML_ROWS) * DM, XC + (size_t)(row - ML_ROWS) * DM);
                if (l == 0 && !lat) {
#pragma unroll
                    for (int j = 0; j < 4; ++j) *(f32x4*)(XC + (size_t)(row - ML_ROWS) * DM + 4 * lane + 256 * j) = *(const f32x4*)(xr + 4 * lane + 256 * j); } }
        }
        xcd_barrier(xbar);
        {
            pg8::Sched S; S.init(AB, WIN, DM, DM, 68, 37, 1, 1, 0, 0, 0, 0, G, bx, true);
            EpiInproj E{U, GG, P.ml_gate_b + l * 16, ROPE};
            pg8::gemm_phase(lds, pg8::Gemm{DM, DM, DM}, S, E);
            pg8::Sched S2; S2.init(WIN + (size_t)8448 * DM, AB, DM, DM, 12, 68, 1, 1, 0, 0, 0, 0, G, bx, true);
            EpiTT E2{TT, KT};
            pg8::gemm_phase(lds, pg8::Gemm{DM, DM, DM}, S2, E2);
        }
        xcd_barrier(xbar);
        {
            {
                int tf = threadIdx.x; asm volatile("" : "+v"(tf)); const int lf = tf & 63, gwf = bx * 8 + (tf >> 6);
                for (int pr = gwf; pr < NB * 2047; pr += 2 * NGW) {
                    const int pr2 = pr + NGW; const bool ok2 = pr2 < NB * 2047; const int q2 = ok2 ? pr2 : pr;
                    const int b1 = pr / 2047, t1 = pr - b1 * 2047 + 1, b2 = q2 / 2047, t2 = q2 - b2 * 2047 + 1;
                    bf16_t* ra1 = U + (size_t)(b1 * SEQ + t1) * LDU + U_FN + lf * 16; bf16_t* rb1 = U + (size_t)(b1 * SEQ + SEQ - t1) * LDU + U_FN + lf * 16;
                    bf16_t* ra2 = U + (size_t)(b2 * SEQ + t2) * LDU + U_FN + lf * 16; bf16_t* rb2 = U + (size_t)(b2 * SEQ + SEQ - t2) * LDU + U_FN + lf * 16;
                    u32x4 xa[2][2], xb[2][2];
#pragma unroll
                    for (int i = 0; i < 2; ++i) { xa[0][i] = *(const u32x4*)(ra1 + 8 * i); xb[0][i] = *(const u32x4*)(rb1 + 8 * i); xa[1][i] = *(const u32x4*)(ra2 + 8 * i); xb[1][i] = *(const u32x4*)(rb2 + 8 * i); }
#pragma unroll
                    for (int q = 0; q < 2; ++q) { if (q == 1 && !ok2) break; bf16_t* ra = q ? ra2 : ra1; bf16_t* rb = q ? rb2 : rb1;
#pragma unroll
                        for (int i = 0; i < 2; ++i) {
                            const unsigned a4[4] = {xa[q][i].x, xa[q][i].y, xa[q][i].z, xa[q][i].w}, b4[4] = {xb[q][i].x, xb[q][i].y, xb[q][i].z, xb[q][i].w}; unsigned p4[4], m4[4];
#pragma unroll
                            for (int e = 0; e < 4; ++e) { const float al = __uint_as_float(a4[e] << 16), ah = __uint_as_float(a4[e] & 0xffff0000u), bl = __uint_as_float(b4[e] << 16), bh = __uint_as_float(b4[e] & 0xffff0000u);
                                p4[e] = cvt_pk_bf16(al + bl, ah + bh); m4[e] = cvt_pk_bf16(al - bl, ah - bh); }
                            *(u32x4*)(ra + 8 * i) = (u32x4){p4[0], p4[1], p4[2], p4[3]}; *(u32x4*)(rb + 8 * i) = (u32x4){m4[0], m4[1], m4[2], m4[3]}; } }
                }
            }
            for (int u = vcu; u < 256; u += G) mlstm_state_unit(lds, KT, TT, GG, CT, NST, MST, u >> 3, u & 7);
            float lam;
            { const float* lq = P.da_lam + (size_t)l * 256; float s1 = 0.f, s2 = 0.f;
              for (int i = 0; i < 64; ++i) { s1 += lq[i] * lq[64 + i]; s2 += lq[128 + i] * lq[192 + i]; }
              lam = expf(s1) - expf(s2) + lam_init; }
            const int natt = need_ctx ? 1088 : 1024;
            for (int a = vcu; a < natt; a += G) {
                if (a < 1024) { const int bh = a >> 5, qb = a & 31, b = bh >> 3, h = bh & 7;
                    attn_unit(lds, U, TT, P.da_head_g + (size_t)l * DM, lam, 1.0f - lam_init, h, b * SEQ + 128 * qb, b * SEQ, 64, ML_ROWS + b * CTXL, 4); }
                else { const int bh = (a - 1024) >> 1, hf = a & 1, b = bh >> 3, h = bh & 7;
                    attn_unit(lds, U, TT, P.da_head_g + (size_t)l * DM, lam, 1.0f - lam_init, h, ML_ROWS + b * CTXL + 128 * hf, ML_ROWS + b * CTXL, 4, 0, 0); }
            }
        }
        xcd_barrier(xbar);
        {
            const int nm2 = need_ctx ? 16 * NCH : 16 * 32;
            for (int u = vcu; u < nm2; u += G) { const int bh = need_ctx ? u / NCH : u >> 5, loc = need_ctx ? u % NCH : 2 + (u & 31); mlstm_out_unit(lds, U, TT, GG, CT, NST, MST, P.ml_head_g + (size_t)l * DM, bh >> 2, bh & 3, loc); }
            __syncthreads();
            {
                const int f1c = (G == 256 && need_ctx) ? ((bx & 7) ? bx - (bx >> 3) - 1 : 224 + (bx >> 3) + 48) : bx;
                pg8::Sched S; S.init(Wc, U + U_FN, 256, LDU, 2, 16, 16, 4, 0, 0, (size_t)SEQ * LDU * 2, 512, (G == 256 && need_ctx) ? 224 : G, f1c, false);
                S.fold = true; S.nwg = 17 * 16;
                EpiF1Fold E{AT};
                pg8::gemm_phase(lds, pg8::Gemm{256, LDU, 256}, S, E);
            }
            if (need_ctx) {
                pg8::Sched S; S.init(Wc, U + (size_t)ML_ROWS * LDU + U_FN, 256, LDU, 2, 1, 16, 4, 0, 0, (size_t)CTXL * LDU * 2, 512, G, bx, false);
                EpiF1 E{ATC, CTXL};
                pg8::gemm_phase(lds, pg8::Gemm{256, LDU, 256}, S, E);
            }
            if (l + 1 < DEPTH && (G != 256 || (bx & 7))) convert_dynamic(P, lds, l + 1, 0, 10, CTR + 4 * l, 1);
        }
        xcd_barrier(xbar);
        {
            {
                pg8::Sched S; S.init(Dm, AT, 4096, 4096, 16, 4, 4, 1, 0, 0, (size_t)1024 * 4096 * 2, 0, G, bx, false);
                EpiF2 E{U, 0, SEQ};
                pg8::gemm_phase(lds, pg8::Gemm{4096, 4096, 4096}, S, E);
            }
            if (need_ctx) {
                pg8::Sched S; S.init(Dc, ATC, 512, 512, 1, 4, 4, 1, 0, 0, (size_t)1024 * 512 * 2, 0, G, bx, false);
                EpiF2 E{U, ML_ROWS, CTXL};
                pg8::gemm_phase(lds, pg8::Gemm{512, 512, 512}, S, E);
            }
        }
        xcd_barrier(xbar);
        {
            { pg8::Sched S; S.init(U + U_OG, WBR, LDU, DM, 64, 4, 1, 1, 0, 0, 0, 0, G, bx, true); EpiMerge<0> E{U, (bf16_t*)Y, AB}; pg8::gemm_phase(lds, pg8::Gemm{LDU, DM, DM}, S, E); }
            { pg8::Sched S; S.init(U + U_DAQ, WBR + (size_t)DM * DM, LDU, DM, 64, 4, 1, 1, 0, 0, 0, 0, G, bx, true); EpiMerge<1> E{U, (bf16_t*)Y, AB}; pg8::gemm_phase(lds, pg8::Gemm{LDU, DM, DM}, S, E); }
            { pg8::Sched S; S.init(U + U_FN, WBR + (size_t)2 * DM * DM, LDU, DM, 64, 4, 1, 1, 0, 0, 0, 0, G, bx, true); EpiMerge<2> E{U, (bf16_t*)Y, AB}; pg8::gemm_phase(lds, pg8::Gemm{LDU, DM, DM}, S, E); }
            if (need_ctx) {
                const bf16_t* Uc = U + (size_t)ML_ROWS * LDU;
                { pg8::Sched S; S.init(Uc + U_OG, WBR, LDU, DM, 4, 4, 1, 1, 0, 0, 0, 0, G, (bx + 48) % G, false); EpiMergeCtx E{U, YC, 0}; pg8::gemm_phase(lds, pg8::Gemm{LDU, DM, DM}, S, E); }
                { pg8::Sched S; S.init(Uc + U_DAQ, WBR + (size_t)DM * DM, LDU, DM, 4, 4, 1, 1, 0, 0, 0, 0, G, (bx + 32) % G, false); EpiMergeCtx E{U, YC + (size_t)MC_ROWS * DM, 1}; pg8::gemm_phase(lds, pg8::Gemm{LDU, DM, DM}, S, E); }
                { pg8::Sched S; S.init(Uc + U_FN, WBR + (size_t)2 * DM * DM, LDU, DM, 4, 4, 1, 1, 0, 0, 0, 0, G, (bx + 16) % G, false); EpiMergeCtx E{U, YC + (size_t)2 * MC_ROWS * DM, 2}; pg8::gemm_phase(lds, pg8::Gemm{LDU, DM, DM}, S, E); }
            }
            if (l + 1 < DEPTH) convert_dynamic(P, lds, l + 1, 0, 10, CTR + 4 * l);
        }
        xcd_barrier(xbar);
        if (need_ctx) {
            int t5 = threadIdx.x; asm volatile("" : "+v"(t5)); const int l5 = t5 & 63, gw5 = bx * 8 + (t5 >> 6);
            for (int row = gw5; row < MC_ROWS; row += NGW) {
#pragma unroll
                for (int j = 0; j < 4; ++j) { const size_t o = (size_t)row * DM + 4 * l5 + 256 * j;
                    const f32x4 y = *(const f32x4*)(YC + o) + *(const f32x4*)(YC + (size_t)MC_ROWS * DM + o) + *(const f32x4*)(YC + (size_t)2 * MC_ROWS * DM + o);
                    u32x2 w; w.x = cvt_pk_bf16(y[0], y[1]); w.y = cvt_pk_bf16(y[2], y[3]); *(u32x2*)(AB + (size_t)(ML_ROWS + row) * DM + 4 * l5 + 256 * j) = w; }
            }
            xcd_barrier(xbar);
        }
        {
            pg8::Sched S; S.init(AB, WOUT, DM, DM, 64, 4, 1, 1, 0, 0, 0, 0, G, bx, true);
            EpiResid E{srcL, srcC, P.out, XC, mods + 2 * 1024};
            pg8::gemm_phase(lds, pg8::Gemm{DM, DM, DM}, S, E);
            if (need_ctx) {
                pg8::Sched S2; S2.init(AB + (size_t)ML_ROWS * DM, WOUT, DM, DM, 4, 4, 2, 1, 1024, 0, 1024, 0, G, (bx + 112) % G, false);
                EpiResidCtxHalf E2{XC, TP6, mods + 4 * 6144 + 2 * 1024};
                pg8::gemm_phase(lds, pg8::Gemm{DM, DM, 512}, S2, E2);
            }
            if (l + 1 < DEPTH) convert_dynamic(P, lds, l + 1, 10, 13, CTR + 4 * l + 1);
        }
        xcd_barrier(xbar);
        {
            const int nrows = need_ctx ? MROWS : ML_ROWS;
            int tid7 = threadIdx.x; asm volatile("" : "+v"(tid7)); const int lane = tid7 & 63, gw = bx * 8 + (tid7 >> 6);
            for (int row = gw; row < nrows; row += NGW) { const bool lat = row < ML_ROWS; const int s = lat ? row >> 12 : 4;
                const float* xr = lat ? P.out + (size_t)row * DM : XC + (size_t)(row - ML_ROWS) * DM;
                if (lat) norm_mod_row(xr, P.norm_g + (size_t)(l * 2 + 1) * DM, mods + s * 6144 + 3 * 1024, mods + s * 6144 + 4 * 1024, AB + (size_t)row * DM, lane);
                else norm_mod_row(xr, P.norm_g + (size_t)(l * 2 + 1) * DM, mods + s * 6144 + 3 * 1024, mods + s * 6144 + 4 * 1024, AB + (size_t)row * DM, lane, TP6 + (size_t)(row - ML_ROWS) * DM, XC + (size_t)(row - ML_ROWS) * DM); }
        }
        xcd_barrier(xbar);
        {
            pg8::Sched S; S.init(AB, WF1, DM, DM, nMr, 22, 1, 1, 0, 0, 0, 0, G, bx, true);
            EpiSwiglu E{HID};
            pg8::gemm_phase(lds, pg8::Gemm{DM, DM, DM}, S, E);
        }
        xcd_barrier(xbar);
        {
            pg8::Sched S; S.init(HID, WF2, DFF, DFF, 64, 4, 1, 1, 0, 0, 0, 0, G, bx, true);
            EpiResid E{P.out, XC, P.out, XC, mods + 5 * 1024};
            pg8::gemm_phase(lds, pg8::Gemm{DFF, DFF, DFF}, S, E);
            if (need_ctx) {
                pg8::Sched S2; S2.init(HID + (size_t)ML_ROWS * DFF, WF2, DFF, DFF, 4, 4, 2, 1, 2816, 0, 2816, 0, G, (bx + 112) % G, false);
                EpiResidCtxHalf E2{XC, TP9, mods + 4 * 6144 + 5 * 1024};
                pg8::gemm_phase(lds, pg8::Gemm{DFF, DFF, 1408}, S2, E2);
            }
            if (l + 1 < DEPTH) convert_dynamic(P, lds, l + 1, 13, 15, CTR + 4 * l + 2);
        }
        xcd_barrier(xbar);
    }
    int tidf = threadIdx.x; asm volatile("" : "+v"(tidf));
    const int lane = tidf & 63, gw = bx * 8 + (tidf >> 6);
    for (int row = gw; row < ML_ROWS; row += NGW) {
        float* xr = P.out + (size_t)row * DM; f32x4 v[4]; float s = 0.f;
#pragma unroll
        for (int j = 0; j < 4; ++j) { v[j] = *(const f32x4*)(xr + 4 * lane + 256 * j); s += (v[j][0] * v[j][0] + v[j][1] * v[j][1]) + (v[j][2] * v[j][2] + v[j][3] * v[j][3]); }
        const float rn = 1.0f / sqrtf(wave_sum(s) * (1.0f / DM) + EPS);
#pragma unroll
        for (int j = 0; j < 4; ++j) *(f32x4*)(xr + 4 * lane + 256 * j) = v[j] * rn * *(const f32x4*)(P.final_g + 4 * lane + 256 * j);
    }
}

extern "C" void kernel_launch(void* const* d_in, const int* in_sizes, int n_in, void* d_out, int out_size, void* d_ws, size_t ws_size, hipStream_t stream) {
    static int grid_blocks = 0;
    if (grid_blocks == 0) {
        if (n_in != 19 || ws_size < WS_END) { fprintf(stderr, "kernel_launch: need 19 inputs and %zu bytes of workspace (got %d, %zu)\n", (size_t)WS_END, n_in, ws_size); grid_blocks = -1; return; }
        int dev = 0, cus = 0, per_cu = 0;
        hipGetDevice(&dev);
        hipDeviceGetAttribute(&cus, hipDeviceAttributeMultiprocessorCount, dev);
        hipFuncSetAttribute((const void*)fwd_megakernel, hipFuncAttributeMaxDynamicSharedMemorySize, LDS_BYTES);
        hipOccupancyMaxActiveBlocksPerMultiprocessor(&per_cu, (const void*)fwd_megakernel, 512, LDS_BYTES);
        if (per_cu < 1) per_cu = 1;
        grid_blocks = cus * per_cu;
    }
    if (grid_blocks < 0) return;
    Params p{};
    const float** pp = (const float**)&p;
    for (int i = 0; i < 19; ++i) pp[i] = (const float*)d_in[i];
    p.out = (float*)d_out; p.ws = (unsigned char*)d_ws;
    (void)hipMemsetAsync((char*)d_ws + WS_CTR, 0, 256 + 3456 * 4, stream);
    void* args[] = {&p};
    hipError_t e = hipLaunchCooperativeKernel((const void*)fwd_megakernel, dim3(grid_blocks), dim3(512), args, LDS_BYTES, stream);
    if (e != hipSuccess) fprintf(stderr, "cooperative launch failed: %s (grid %d)\n", hipGetErrorString(e), grid_blocks);
}
```

```cpp
#include <hip/hip_runtime.h>
#include <hip/hip_cooperative_groups.h>
#include <cstdio>
#include <cstdint>
namespace cg = cooperative_groups;

#define LAS __attribute__((address_space(3)))
typedef unsigned short bf16_t;
typedef short bf16x8 __attribute__((ext_vector_type(8)));
typedef float f32x4 __attribute__((ext_vector_type(4)));
typedef float f32x2 __attribute__((ext_vector_type(2)));
typedef unsigned u32x4 __attribute__((ext_vector_type(4)));
typedef unsigned u32x2 __attribute__((ext_vector_type(2)));
typedef LAS unsigned char* ldsp;

constexpr int DM = 1024, NB = 4, SEQ = 4096, CTXL = 256, DEPTH = 4;
constexpr int ML_ROWS = NB * SEQ;
constexpr int MC_ROWS = NB * CTXL;
constexpr int MROWS = ML_ROWS + MC_ROWS;
constexpr int DIN = 11280, DFF = 2816;
constexpr float EPS = 1e-6f;
constexpr int LDU = 9216;
constexpr int U_GP = 0, U_FN = 3072, U_DAK = 4096, U_DAQ = 5120, U_OG = 6144, U_MLQ = 7168, U_MLK = 8192;
constexpr int WIN_ROWS = 11520, WIN_MAIN = 9472, WIN_MLV = 9472, WIN_DAV = 10496;
constexpr int LDT = MROWS;
constexpr int NCH = 34;
constexpr float QSCALE = 0.125f * 1.4426950408889634f;

constexpr size_t MiB = 1u << 20;
constexpr size_t WS_WIN = 0;
constexpr size_t WS_WBR = WS_WIN + (size_t)WIN_ROWS * DM * 2;
constexpr size_t WS_WOUT = WS_WBR + 3 * (size_t)DM * DM * 2;
constexpr size_t WS_WF1 = WS_WOUT + (size_t)DM * DM * 2;
constexpr size_t WS_WF2 = WS_WF1 + (size_t)2 * DFF * DM * 2;
constexpr size_t WS_WEND = WS_WF2 + (size_t)DM * DFF * 2;
constexpr size_t WS_U = 52 * MiB;
constexpr size_t WS_TT = WS_U + (size_t)MROWS * LDU * 2;
constexpr size_t WS_XC = WS_TT + (size_t)2048 * LDT * 2;
constexpr size_t WS_AB = WS_XC + (size_t)MC_ROWS * DM * 4;
constexpr size_t WS_ATC = WS_AB + (size_t)NB * 1024 * 8192 * 2;
constexpr size_t WS_KT = WS_AB + (size_t)34 * MiB;
static_assert(WS_KT >= WS_AB + (size_t)MROWS * DM * 2 && WS_KT + (size_t)1024 * LDT * 2 <= WS_ATC + (size_t)NB * 1024 * 512 * 2, "KT overlay");
constexpr size_t WS_D = WS_ATC + (size_t)NB * 1024 * 512 * 2;
constexpr size_t WS_DC = WS_D + (size_t)4096 * 8192 * 2;
constexpr size_t WS_WC = WS_DC + (size_t)256 * 512 * 2;
constexpr size_t WS_ROPE = WS_WC + (size_t)512 * 256 * 2;
constexpr size_t WS_MODS = WS_ROPE + (size_t)4096 * 64 * 4;
constexpr size_t WS_G = WS_MODS + (size_t)DEPTH * 5 * 6144 * 4;
constexpr size_t WS_NST = WS_G + (size_t)MROWS * 16 * 4;
constexpr size_t WS_MST = WS_NST + (size_t)32 * NCH * 256 * 4;
constexpr size_t WS_CTR = WS_MST + 32 * NCH * 4;
constexpr size_t WS_BAR = WS_CTR + 256;
constexpr size_t WS_CT = ((WS_BAR + 3456 * 4 + 255) / 256) * 256;
constexpr size_t WS_END = WS_CT + (size_t)32 * NCH * 65536 * 2;
static_assert(WS_WEND <= WS_U, "weights fit");
static_assert((size_t)MROWS * DM * 4 <= (size_t)32 * NCH * 65536 * 2, "Y overlay fits");
static_assert((size_t)MROWS * DFF * 2 <= (size_t)MROWS * LDU * 2, "hidden overlay fits");

constexpr int LDS_BYTES = 155648;

__device__ __forceinline__ unsigned cvt_pk_bf16(float lo, float hi) { unsigned r; asm volatile("v_cvt_pk_bf16_f32 %0, %1, %2" : "=v"(r) : "v"(lo), "v"(hi)); return r; }
__device__ __forceinline__ float bf2f(bf16_t v) { return __uint_as_float((unsigned)v << 16); }
__device__ __forceinline__ float sigmoidf_(float x) { return 1.0f / (1.0f + __expf(-x)); }
__device__ __forceinline__ f32x4 mfma16(bf16x8 a, bf16x8 b, f32x4 c) { return __builtin_amdgcn_mfma_f32_16x16x32_bf16(a, b, c, 0, 0, 0); }
__device__ __forceinline__ float wave_sum(float v) {
#pragma unroll
    for (int o = 1; o < 64; o <<= 1) v += __shfl_xor(v, o);
    return v;
}

namespace pg8 {
constexpr int BM = 256, BK = 64, HALF = 128, HTB = HALF * BK * 2, STAGE_BYTES = 8 * HTB, NXCD = 8, WGM = 8;
__host__ __device__ __forceinline__ int lds_byte(int r, int c) { const int st = (r >> 4) * 2 + (c >> 5), rr = r & 15, cc = c & 31, ob = rr * 64 + cc * 2; return st * 1024 + (ob ^ (((ob >> 9) & 1) << 5)); }
__host__ __device__ __forceinline__ void stage_rc(int b, int& R, int& C) { const int st = b / 1024, sb = b % 1024, swz = sb ^ (((sb >> 9) & 1) << 5); R = (st >> 1) * 16 + swz / 64; C = (st & 1) * 32 + (swz % 64) / 2; }
__host__ __device__ __forceinline__ int perm32(int rho) { const int n = rho >> 4, i = rho & 15; return 8 * (i >> 2) + 4 * n + (i & 3); }

struct Unit { const char* A; const char* B; int pm, pn, job; };
struct Gemm { int lda, ldb, K; };

struct Sched {
    const char* A0; const char* B0; size_t tA, tB, s1A, s2A, s1B, s2B; int nM, nN, nj2, nwg, G, c; bool swz; bool fold;
    __device__ __forceinline__ void init(const void* A, const void* B, int lda, int ldb, int nM_, int nN_, int njobs, int nj2_, size_t s1A_, size_t s2A_, size_t s1B_, size_t s2B_, int G_, int c_, bool swz_) {
        A0 = (const char*)A; B0 = (const char*)B; tA = (size_t)BM * lda * 2; tB = (size_t)BM * ldb * 2; s1A = s1A_; s2A = s2A_; s1B = s1B_; s2B = s2B_;
        nM = nM_; nN = nN_; nj2 = nj2_; nwg = nM_ * nN_ * njobs; G = G_; c = c_; swz = swz_; fold = false;
    }
    __device__ __forceinline__ bool next(int i, Unit& u) const {
        const long L = (long)i * G + c; if (L >= nwg) return false;
        int wgid = (int)L, job = 0, pm, pn;
        if (swz) {
            { const int q = nwg / NXCD, r = nwg % NXCD, xcd = wgid % NXCD, off = wgid / NXCD; wgid = (xcd < r ? xcd * (q + 1) : r * (q + 1) + (xcd - r) * q) + off; }
            const int nig = WGM * nN, gid = wgid / nig, fm = gid * WGM, gsz = (nM - fm) < WGM ? (nM - fm) : WGM;
            pm = fm + ((wgid % nig) % gsz); pn = (wgid % nig) / gsz;
        } else {
            if (fold) { job = wgid / 17; const int rem = wgid - job * 17; pm = rem < 9 ? 0 : 1; pn = rem < 9 ? rem : rem - 1; }
            else { const int per = nM * nN; job = wgid / per; const int rem = wgid - job * per; pn = rem / nM; pm = rem - pn * nM; }
        }
        const int j1 = job / nj2, j2 = job - j1 * nj2;
        u.pm = pm; u.pn = pn; u.job = job;
        u.A = A0 + (size_t)j1 * s1A + (size_t)j2 * s2A + (size_t)pm * tA;
        u.B = B0 + (size_t)j1 * s1B + (size_t)j2 * s2B + (size_t)pn * tB;
        return true;
    }
};

template <class Epi>
__device__ __forceinline__ void gemm_phase(ldsp lds, const Gemm g, const Sched& S, const Epi& E) {
    int tid = threadIdx.x; asm volatile("" : "+v"(tid)); const int wid = __builtin_amdgcn_readfirstlane(tid >> 6), lane = tid & 63, wr = wid >> 2, wc = wid & 3, fr = lane & 15, fq = lane >> 4;
    int K = g.K; asm volatile("" : "+s"(K)); const int nt = K / BK;
    unsigned voffA[2], voffB[2];
#pragma unroll
    for (int i = 0; i < 2; ++i) { int R, C; stage_rc(tid * 16 + i * 8192, R, C); const int Rb = (R & ~31) + perm32(R & 31);
        voffA[i] = (unsigned)(R * g.lda + C) * 2u; voffB[i] = (unsigned)(Rb * g.ldb + C) * 2u; }
    const size_t kstep = (size_t)(BK * 2);
    const size_t hstepA = (size_t)HALF * g.lda * 2, hstepB = (size_t)HALF * g.ldb * 2;
    const unsigned ldsw = (unsigned)wid * 1024u;
    const int aoff = lds_byte(wr * 64 + fr, fq * 8), boff = lds_byte(wc * 32 + fr, fq * 8);
#define PG8_SA(b, h) (((b) * 2 + (h)) * HTB)
#define PG8_SB(b, h) ((4 + (b) * 2 + (h)) * HTB)
#define PG8_STAGE(bufoff, gbase, voff) do { _Pragma("unroll") for (int _i = 0; _i < 2; ++_i) \
        __builtin_amdgcn_global_load_lds((const unsigned*)((const char*)(gbase) + (voff)[_i]), (LAS unsigned*)(lds + (bufoff) + ldsw + _i * 8192), 16, 0, 0); } while (0)
#define PG8_LDA(dst, b, h) do { _Pragma("unroll") for (int m = 0; m < 4; ++m) _Pragma("unroll") for (int k = 0; k < 2; ++k) dst[m][k] = *(const LAS bf16x8*)(lds + PG8_SA(b, h) + aoff + m * 2048 + k * 1024); } while (0)
#define PG8_LDB(dst, b, h) do { _Pragma("unroll") for (int n = 0; n < 2; ++n) _Pragma("unroll") for (int k = 0; k < 2; ++k) dst[n][k] = *(const LAS bf16x8*)(lds + PG8_SB(b, h) + boff + n * 2048 + k * 1024); } while (0)
#define PG8_MMA(ai, bj, At, Bt) do { __builtin_amdgcn_s_setprio(1); _Pragma("unroll") for (int m = 0; m < 4; ++m) _Pragma("unroll") for (int n = 0; n < 2; ++n) _Pragma("unroll") for (int k = 0; k < 2; ++k) \
        acc[ai][bj][m][n] = __builtin_amdgcn_mfma_f32_16x16x32_bf16(Bt[n][k], At[m][k], acc[ai][bj][m][n], 0, 0, 0); __builtin_amdgcn_s_setprio(0); } while (0)
#define PG8_WAIT_V(n) asm volatile("s_waitcnt vmcnt(" #n ")" ::: "memory")
#define PG8_WAIT_L(n) asm volatile("s_waitcnt lgkmcnt(" #n ")" ::: "memory")
#define PG8_BAR __builtin_amdgcn_s_barrier()
#define PG8_SCHED __builtin_amdgcn_sched_barrier(0)
    Unit cur, nxt; int ui = 0;
    if (!S.next(0, cur)) return;
    f32x4 acc[2][2][4][2];
#pragma unroll
    for (int a = 0; a < 2; ++a)
#pragma unroll
        for (int b = 0; b < 2; ++b)
#pragma unroll
            for (int m = 0; m < 4; ++m)
#pragma unroll
                for (int n = 0; n < 2; ++n) acc[a][b][m][n] = (f32x4){0.f, 0.f, 0.f, 0.f};
    bf16x8 At[4][2], B0[2][2], B1[2][2];
    const char* cA = cur.A; const char* cB = cur.B;
    PG8_STAGE(PG8_SB(0, 0), cB, voffB); PG8_STAGE(PG8_SB(0, 1), cB + hstepB, voffB); PG8_STAGE(PG8_SA(0, 0), cA, voffA); PG8_STAGE(PG8_SA(0, 1), cA + hstepA, voffA);
    if (wr == 1) PG8_BAR;
    PG8_WAIT_V(2); PG8_BAR;
    PG8_STAGE(PG8_SB(1, 0), cB + kstep, voffB); PG8_STAGE(PG8_SA(1, 0), cA + kstep, voffA); PG8_STAGE(PG8_SB(1, 1), cB + hstepB + kstep, voffB);
    PG8_WAIT_V(6); PG8_BAR;
    for (;;) {
        const bool has_next = S.next(ui + 1, nxt);
        const char* nA = has_next ? nxt.A : cA; const char* nB = has_next ? nxt.B : cB;
#pragma unroll 1
        for (int t = 0; t < nt; t += 2) {
            const bool last = (t == nt - 2);
            const char* a1 = cA + (size_t)(t + 1) * kstep;
            const char* a2 = last ? nA : cA + (size_t)(t + 2) * kstep; const char* b2 = last ? nB : cB + (size_t)(t + 2) * kstep;
            const char* a3 = a2 + kstep; const char* b3 = b2 + kstep;
            PG8_LDB(B0, 0, 0); PG8_LDB(B1, 0, 1); PG8_SCHED; PG8_LDA(At, 0, 0); PG8_STAGE(PG8_SA(1, 1), a1 + hstepA, voffA);
            PG8_WAIT_V(8); PG8_WAIT_L(0); PG8_BAR; PG8_MMA(0, 0, At, B0); PG8_MMA(0, 1, At, B1); PG8_BAR; PG8_SCHED;
            PG8_LDA(At, 0, 1); PG8_STAGE(PG8_SB(0, 0), b2, voffB); PG8_STAGE(PG8_SB(0, 1), b2 + hstepB, voffB); PG8_STAGE(PG8_SA(0, 0), a2, voffA);
            PG8_WAIT_V(8); PG8_WAIT_L(0); PG8_BAR; PG8_MMA(1, 0, At, B0); PG8_MMA(1, 1, At, B1); PG8_BAR; PG8_SCHED;
            PG8_LDB(B0, 1, 0); PG8_LDB(B1, 1, 1); PG8_SCHED; PG8_LDA(At, 1, 0); PG8_STAGE(PG8_SA(0, 1), a2 + hstepA, voffA);
            PG8_WAIT_V(8); PG8_WAIT_L(0); PG8_BAR; PG8_MMA(0, 0, At, B0); PG8_MMA(0, 1, At, B1); PG8_BAR; PG8_SCHED;
            PG8_LDA(At, 1, 1); PG8_STAGE(PG8_SB(1, 0), b3, voffB); PG8_STAGE(PG8_SB(1, 1), b3 + hstepB, voffB); PG8_STAGE(PG8_SA(1, 0), a3, voffA);
            PG8_WAIT_V(8); PG8_WAIT_L(0); PG8_BAR; PG8_MMA(1, 0, At, B0); PG8_MMA(1, 1, At, B1); PG8_BAR; PG8_SCHED;
        }
        if (wr == 0) PG8_BAR;
        E(acc, cur, wr, wc, fr, fq);
        if (!has_next) break;
#pragma unroll
        for (int a = 0; a < 2; ++a)
#pragma unroll
            for (int b = 0; b < 2; ++b)
#pragma unroll
                for (int m = 0; m < 4; ++m)
#pragma unroll
                    for (int n = 0; n < 2; ++n) acc[a][b][m][n] = (f32x4){0.f, 0.f, 0.f, 0.f};
        cur = nxt; cA = nA; cB = nB; ++ui;
        if (wr == 1) PG8_BAR;
    }
    PG8_WAIT_V(0);
    PG8_BAR;
#undef PG8_SA
#undef PG8_SB
#undef PG8_STAGE
#undef PG8_LDA
#undef PG8_LDB
#undef PG8_MMA
#undef PG8_WAIT_V
#undef PG8_WAIT_L
#undef PG8_BAR
#undef PG8_SCHED
}
}
using pg8::Unit;

#define EPI_BEGIN(acc, wr, wc, fr, fq) \
    _Pragma("unroll") for (int ai = 0; ai < 2; ++ai) _Pragma("unroll") for (int m = 0; m < 4; ++m) _Pragma("unroll") for (int bj = 0; bj < 2; ++bj) { \
        const int rt = ai * 128 + wr * 64 + m * 16 + fr, ct = bj * 128 + wc * 32 + fq * 8; f32x4 v0 = acc[ai][bj][m][0], v1 = acc[ai][bj][m][1];
#define EPI_END }

__device__ __forceinline__ u32x4 pack8(f32x4 v0, f32x4 v1) { u32x4 w; w.x = cvt_pk_bf16(v0[0], v0[1]); w.y = cvt_pk_bf16(v0[2], v0[3]); w.z = cvt_pk_bf16(v1[0], v1[1]); w.w = cvt_pk_bf16(v1[2], v1[3]); return w; }

struct EpiInproj {
    bf16_t* U; float* G; const float* gate_b; const float* rope;
    __device__ __forceinline__ void operator()(const f32x4 (&acc)[2][2][4][2], const Unit& u, int wr, int wc, int fr, int fq) const {
        const int row0 = u.pm * 256;
        if (u.pn == 0) {
            if (wc == 0 && fq < 2) {
                f32x4 b0 = *(const f32x4*)(gate_b + 8 * fq), b1 = *(const f32x4*)(gate_b + 8 * fq + 4);
#pragma unroll
                for (int ai = 0; ai < 2; ++ai)
#pragma unroll
                    for (int m = 0; m < 4; ++m) { const int row = row0 + ai * 128 + wr * 64 + m * 16 + fr;
                        *(f32x4*)(G + (size_t)row * 16 + 8 * fq) = acc[ai][0][m][0] + b0; *(f32x4*)(G + (size_t)row * 16 + 8 * fq + 4) = acc[ai][0][m][1] + b1; }
            }
            return;
        }
        const int ucol0 = (u.pn - 1) * 256;
        const int seg = ucol0 < U_FN ? 0 : (ucol0 >> 10);
        const bool latent = row0 < ML_ROWS;
        EPI_BEGIN(acc, wr, wc, fr, fq) {
            const int row = row0 + rt, col = ucol0 + ct;
            if (seg == 0 || seg == 6) {
#pragma unroll
                for (int j = 0; j < 4; ++j) { v0[j] = sigmoidf_(v0[j]); v1[j] = sigmoidf_(v1[j]); }
            } else if (seg == 4 || seg == 5) {
                if (latent) {
                    const int t = row & (SEQ - 1), ib = (col & 63) >> 1;
                    const f32x4 cs0 = *(const f32x4*)(rope + ((size_t)t * 32 + ib) * 2), cs1 = *(const f32x4*)(rope + ((size_t)t * 32 + ib) * 2 + 4);
                    f32x4 w0, w1;
                    w0[0] = v0[0] * cs0[0] - v0[1] * cs0[1]; w0[1] = v0[0] * cs0[1] + v0[1] * cs0[0];
                    w0[2] = v0[2] * cs0[2] - v0[3] * cs0[3]; w0[3] = v0[2] * cs0[3] + v0[3] * cs0[2];
                    w1[0] = v1[0] * cs1[0] - v1[1] * cs1[1]; w1[1] = v1[0] * cs1[1] + v1[1] * cs1[0];
                    w1[2] = v1[2] * cs1[2] - v1[3] * cs1[3]; w1[3] = v1[2] * cs1[3] + v1[3] * cs1[2];
                    v0 = w0; v1 = w1;
                }
                if (seg == 5) { v0 = v0 * QSCALE; v1 = v1 * QSCALE; }
            } else if (seg == 8) { v0 = v0 * 0.0625f; v1 = v1 * 0.0625f; }
            *(u32x4*)(U + (size_t)row * LDU + col) = pack8(v0, v1);
        } EPI_END
    }
};
struct EpiTT {
    bf16_t* TT; bf16_t* KT;
    __device__ __forceinline__ void operator()(const f32x4 (&acc)[2][2][4][2], const Unit& u, int wr, int wc, int fr, int fq) const {
        bf16_t* base = u.pm < 4 ? KT + (size_t)(u.pm * 256) * LDT : TT + (size_t)((u.pm - 4) * 256) * LDT;
        const float sc = u.pm < 4 ? 0.0625f : 1.0f;
        if (u.pm < 8) {
            EPI_BEGIN(acc, wr, wc, fr, fq) { *(u32x4*)(base + (size_t)rt * LDT + u.pn * 256 + ct) = pack8(v0 * sc, v1 * sc); } EPI_END
        } else {
            EPI_BEGIN(acc, wr, wc, fr, fq) {
                const int m8 = (ct >> 3) & 3, hh = m8 >> 1, q0 = 2 * (m8 & 1);
                bf16_t* p = base + (size_t)rt * LDT + u.pn * 256 + (ct & ~31);
                u32x2 w0; w0.x = cvt_pk_bf16(v0[0], v0[1]); w0.y = cvt_pk_bf16(v0[2], v0[3]);
                u32x2 w1; w1.x = cvt_pk_bf16(v1[0], v1[1]); w1.y = cvt_pk_bf16(v1[2], v1[3]);
                *(u32x2*)(p + 8 * q0 + 4 * hh) = w0; *(u32x2*)(p + 8 * (q0 + 1) + 4 * hh) = w1;
            } EPI_END
        }
    }
};
struct EpiF1 {
    bf16_t* AT; int Tn;
    __device__ __forceinline__ void operator()(const f32x4 (&acc)[2][2][4][2], const Unit& u, int wr, int wc, int fr, int fq) const {
        const int b = u.job >> 2, g = u.job & 3;
        EPI_BEGIN(acc, wr, wc, fr, fq) { *(u32x4*)(AT + ((size_t)((b * 1024 + 256 * g + rt) * 2 + u.pm)) * Tn + u.pn * 256 + ct) = pack8(v0, v1); } EPI_END
    }
};
struct EpiF1Fold {
    bf16_t* AT;
    __device__ __forceinline__ void operator()(const f32x4 (&acc)[2][2][4][2], const Unit& u, int wr, int wc, int fr, int fq) const {
        const int b = u.job >> 2, g = u.job & 3;
        EPI_BEGIN(acc, wr, wc, fr, fq) {
            bf16_t* p = AT + (size_t)(b * 1024 + 256 * g + rt) * 4096 + u.pn * 256 + ct;
            const u32x4 w = pack8(v0, v1);
            if (u.pn != 8) *(u32x4*)p = w;
            else if (u.pm == 0) { if (ct == 0) p[0] = (bf16_t)(w.x & 0xffffu); }
            else { if (ct != 0) *(u32x4*)p = w;
                   else { p[1] = (bf16_t)(w.x >> 16); *(unsigned*)(p + 2) = w.y; *(unsigned*)(p + 4) = w.z; *(unsigned*)(p + 6) = w.w; } }
        } EPI_END
    }
};
struct EpiF2 {
    bf16_t* U; int rowbase, Tn;
    __device__ __forceinline__ void operator()(const f32x4 (&acc)[2][2][4][2], const Unit& u, int wr, int wc, int fr, int fq) const {
        EPI_BEGIN(acc, wr, wc, fr, fq) { *(u32x4*)(U + (size_t)(rowbase + u.job * Tn + u.pm * 256 + rt) * LDU + U_FN + u.pn * 256 + ct) = pack8(v0, v1); } EPI_END
    }
};
template <int PASS> struct EpiMerge {
    const bf16_t* U; bf16_t* Y; bf16_t* AB;
    __device__ __forceinline__ void operator()(const f32x4 (&acc)[2][2][4][2], const Unit& u, int wr, int wc, int fr, int fq) const {
        EPI_BEGIN(acc, wr, wc, fr, fq) {
            const int row = u.pm * 256 + rt, col = u.pn * 256 + ct;
            const u32x4 gw = *(const u32x4*)(U + (size_t)row * LDU + U_GP + 1024 * PASS + col);
            f32x4 g0, g1;
            g0[0] = __uint_as_float(gw.x << 16); g0[1] = __uint_as_float(gw.x & 0xffff0000u); g0[2] = __uint_as_float(gw.y << 16); g0[3] = __uint_as_float(gw.y & 0xffff0000u);
            g1[0] = __uint_as_float(gw.z << 16); g1[1] = __uint_as_float(gw.z & 0xffff0000u); g1[2] = __uint_as_float(gw.w << 16); g1[3] = __uint_as_float(gw.w & 0xffff0000u);
            v0 = v0 * g0; v1 = v1 * g1;
            bf16_t* yp = Y + (size_t)row * DM + col;
            if (PASS > 0) { const u32x4 yw = *(const u32x4*)yp;
                v0[0] += __uint_as_float(yw.x << 16); v0[1] += __uint_as_float(yw.x & 0xffff0000u); v0[2] += __uint_as_float(yw.y << 16); v0[3] += __uint_as_float(yw.y & 0xffff0000u);
                v1[0] += __uint_as_float(yw.z << 16); v1[1] += __uint_as_float(yw.z & 0xffff0000u); v1[2] += __uint_as_float(yw.w << 16); v1[3] += __uint_as_float(yw.w & 0xffff0000u); }
            if (PASS < 2) *(u32x4*)yp = pack8(v0, v1);
            else *(u32x4*)(AB + (size_t)row * DM + col) = pack8(v0, v1);
        } EPI_END
    }
};
struct EpiResid {
    const float* srcL; const float* srcC; float* dstL; float* dstC; const float* gate;
    __device__ __forceinline__ void operator()(const f32x4 (&acc)[2][2][4][2], const Unit& u, int wr, int wc, int fr, int fq) const {
        const bool lat = u.pm < 64; const int s = lat ? (u.pm >> 4) : 4;
        const float* src = lat ? srcL + (size_t)u.pm * 256 * DM : srcC + (size_t)(u.pm - 64) * 256 * DM;
        float* dst = lat ? dstL + (size_t)u.pm * 256 * DM : dstC + (size_t)(u.pm - 64) * 256 * DM;
        const float* gp = gate + (size_t)s * 6144;
        EPI_BEGIN(acc, wr, wc, fr, fq) {
            const int col = u.pn * 256 + ct; const size_t off = (size_t)rt * DM + col;
            const f32x4 g0 = *(const f32x4*)(gp + col), g1 = *(const f32x4*)(gp + col + 4);
            *(f32x4*)(dst + off) = *(const f32x4*)(src + off) + g0 * v0; *(f32x4*)(dst + off + 4) = *(const f32x4*)(src + off + 4) + g1 * v1;
        } EPI_END
    }
};
struct EpiResidCtxHalf {
    float* dstC; float* part; const float* gate;
    __device__ __forceinline__ void operator()(const f32x4 (&acc)[2][2][4][2], const Unit& u, int wr, int wc, int fr, int fq) const {
        float* dst = (u.job == 0 ? dstC : part) + (size_t)u.pm * 256 * DM;
        EPI_BEGIN(acc, wr, wc, fr, fq) {
            const int col = u.pn * 256 + ct; float* p = dst + (size_t)rt * DM + col;
            const f32x4 g0 = *(const f32x4*)(gate + col), g1 = *(const f32x4*)(gate + col + 4);
            if (u.job == 0) { *(f32x4*)p = *(const f32x4*)p + g0 * v0; *(f32x4*)(p + 4) = *(const f32x4*)(p + 4) + g1 * v1; }
            else { *(f32x4*)p = g0 * v0; *(f32x4*)(p + 4) = g1 * v1; }
        } EPI_END
    }
};
struct EpiMergeCtx {
    const bf16_t* U; float* Yc; int pass;
    __device__ __forceinline__ void operator()(const f32x4 (&acc)[2][2][4][2], const Unit& u, int wr, int wc, int fr, int fq) const {
        EPI_BEGIN(acc, wr, wc, fr, fq) {
            const int row = u.pm * 256 + rt, col = u.pn * 256 + ct;
            const u32x4 gw = *(const u32x4*)(U + (size_t)(ML_ROWS + row) * LDU + U_GP + 1024 * pass + col);
            f32x4 g0, g1;
            g0[0] = __uint_as_float(gw.x << 16); g0[1] = __uint_as_float(gw.x & 0xffff0000u); g0[2] = __uint_as_float(gw.y << 16); g0[3] = __uint_as_float(gw.y & 0xffff0000u);
            g1[0] = __uint_as_float(gw.z << 16); g1[1] = __uint_as_float(gw.z & 0xffff0000u); g1[2] = __uint_as_float(gw.w << 16); g1[3] = __uint_as_float(gw.w & 0xffff0000u);
            float* yp = Yc + (size_t)row * DM + col;
            *(f32x4*)yp = v0 * g0; *(f32x4*)(yp + 4) = v1 * g1;
        } EPI_END
    }
};
struct EpiSwiglu {
    bf16_t* H;
    __device__ __forceinline__ void operator()(const f32x4 (&acc)[2][2][4][2], const Unit& u, int wr, int wc, int fr, int fq) const {
#pragma unroll
        for (int ai = 0; ai < 2; ++ai)
#pragma unroll
            for (int m = 0; m < 4; ++m) {
                const int row = u.pm * 256 + ai * 128 + wr * 64 + m * 16 + fr, col = u.pn * 128 + wc * 32 + fq * 8;
                f32x4 h0, h1;
#pragma unroll
                for (int j = 0; j < 4; ++j) { const float a0 = acc[ai][0][m][0][j], a1 = acc[ai][0][m][1][j];
                    h0[j] = a0 * sigmoidf_(a0) * acc[ai][1][m][0][j]; h1[j] = a1 * sigmoidf_(a1) * acc[ai][1][m][1][j]; }
                *(u32x4*)(H + (size_t)row * DFF + col) = pack8(h0, h1);
            }
    }
};

__device__ __forceinline__ void norm_mod_row(const float* xr, const float* g, const float* shift, const float* scale, bf16_t* orow, int lane, const float* part = nullptr, float* xw = nullptr) {
    f32x4 v[4]; float s = 0.f;
#pragma unroll
    for (int j = 0; j < 4; ++j) { v[j] = *(const f32x4*)(xr + 4 * lane + 256 * j);
        if (part) { v[j] = v[j] + *(const f32x4*)(part + 4 * lane + 256 * j); *(f32x4*)(xw + 4 * lane + 256 * j) = v[j]; }
        s += (v[j][0] * v[j][0] + v[j][1] * v[j][1]) + (v[j][2] * v[j][2] + v[j][3] * v[j][3]); }
    const float rn = 1.0f / sqrtf(wave_sum(s) * (1.0f / DM) + EPS);
#pragma unroll
    for (int j = 0; j < 4; ++j) { const int c = 4 * lane + 256 * j;
        const f32x4 gg = *(const f32x4*)(g + c), sh = *(const f32x4*)(shift + c), sc = *(const f32x4*)(scale + c);
        f32x4 y = v[j] * rn * gg; y = y * (sc + 1.0f) + sh;
        u32x2 w; w.x = cvt_pk_bf16(y[0], y[1]); w.y = cvt_pk_bf16(y[2], y[3]); *(u32x2*)(orow + c) = w; }
}
__device__ __forceinline__ int dst_row(int perm, int n) {
    if (perm == 1) { const int d = n & 63; return (n & ~63) + (d < 32 ? 2 * d : 2 * (d - 32) + 1); }
    if (perm == 2) { const int j = n < DFF ? n : n - DFF; return 256 * (j >> 7) + (n < DFF ? 0 : 128) + (j & 127); }
    return n;
}
__device__ __forceinline__ void transpose_item(const float* W, int ldn, int src_off, int width, bf16_t* WT, int Kd, int row_off, int perm, LAS float* scr, int kb, int nb, int lane) {
    const int k0 = 64 * kb, n0 = 32 * nb; const bool okc = (n0 + (lane & 31)) < width;
#pragma unroll
    for (int i = 0; i < 32; ++i) { const int kk = 2 * i + (lane >> 5); scr[kk * 33 + (lane & 31)] = okc ? W[(size_t)(k0 + kk) * ldn + src_off + n0 + (lane & 31)] : 0.f; }
    asm volatile("s_waitcnt lgkmcnt(0)" ::: "memory");
    const int c = lane & 7;
#pragma unroll
    for (int j = 0; j < 4; ++j) { const int n = (lane >> 3) + 8 * j; const LAS float* s = scr + (8 * c) * 33 + n;
        u32x4 o; o.x = cvt_pk_bf16(s[0 * 33], s[1 * 33]); o.y = cvt_pk_bf16(s[2 * 33], s[3 * 33]); o.z = cvt_pk_bf16(s[4 * 33], s[5 * 33]); o.w = cvt_pk_bf16(s[6 * 33], s[7 * 33]);
        if (n0 + n < width) *(u32x4*)(WT + (size_t)(row_off + dst_row(perm, n0 + n)) * Kd + k0 + 8 * c) = o; }
    asm volatile("s_waitcnt lgkmcnt(0)" ::: "memory");
}

__device__ __forceinline__ float xmax16(float v) { auto r = __builtin_amdgcn_permlane16_swap(__float_as_uint(v), __float_as_uint(v), false, false); return fmaxf(__uint_as_float(r[0]), __uint_as_float(r[1])); }
__device__ __forceinline__ float xmax32(float v) { auto r = __builtin_amdgcn_permlane32_swap(__float_as_uint(v), __float_as_uint(v), false, false); return fmaxf(__uint_as_float(r[0]), __uint_as_float(r[1])); }
__device__ __forceinline__ float xsum16(float v) { auto r = __builtin_amdgcn_permlane16_swap(__float_as_uint(v), __float_as_uint(v), false, false); return __uint_as_float(r[0]) + __uint_as_float(r[1]); }
__device__ __forceinline__ float xsum32(float v) { auto r = __builtin_amdgcn_permlane32_swap(__float_as_uint(v), __float_as_uint(v), false, false); return __uint_as_float(r[0]) + __uint_as_float(r[1]); }
__device__ __forceinline__ float max3f(float a, float b, float c) { float r; asm("v_max3_f32 %0, %1, %2, %3" : "=v"(r) : "v"(a), "v"(b), "v"(c)); return r; }
__device__ __forceinline__ float max2f(float a, float b) { float r; asm("v_max_f32_e32 %0, %1, %2" : "=v"(r) : "v"(a), "v"(b)); return r; }
__device__ __forceinline__ float xmax16a(float v) { auto r = __builtin_amdgcn_permlane16_swap(__float_as_uint(v), __float_as_uint(v), false, false); return max2f(__uint_as_float(r[0]), __uint_as_float(r[1])); }
__device__ __forceinline__ float xmax32a(float v) { auto r = __builtin_amdgcn_permlane32_swap(__float_as_uint(v), __float_as_uint(v), false, false); return max2f(__uint_as_float(r[0]), __uint_as_float(r[1])); }
constexpr float ATT_THR = 8.0f;
constexpr int ATT_KP = 288, ATT_VP = 160, ATT_KB = 64 * ATT_KP, ATT_VB = 128 * ATT_VP, ATT_BUF = ATT_KB + ATT_VB;
#define SCHED_FENCE() __builtin_amdgcn_sched_barrier(0)
__device__ __forceinline__ void attn_vload(bf16x8 (&vf)[4], ldsp vb, int g, int r, int qq) {
#pragma unroll
    for (int i = 0; i < 4; ++i) { const int c = 2 * g + (i >> 1), u = i & 1;
        vf[i] = *(const LAS bf16x8*)(vb + (16 * c + r) * ATT_VP + (32 * u + 8 * qq) * 2); }
}
__device__ __forceinline__ void attn_tile(ldsp kb, int mapw, const bf16x8 (&qf)[2][2], f32x4 (&O)[2][8], f32x4 (&negm)[2], float (&lrun)[2], bool first, int r, int qq,
                                          const u32x4 (&KR)[2], const u32x4 (&VR)[2], ldsp kst, ldsp vst, bool do_store) {
    ldsp vb = kb + ATT_KB;
    bf16x8 pf[2][2];
    f32x4 s[2][4];
#pragma unroll
    for (int kt = 0; kt < 4; ++kt) {
        const bf16x8 k0 = *(const LAS bf16x8*)(kb + (16 * kt + r) * ATT_KP + (mapw * 64 + qq * 8) * 2);
        const bf16x8 k1 = *(const LAS bf16x8*)(kb + (16 * kt + r) * ATT_KP + (mapw * 64 + 32 + qq * 8) * 2);
#pragma unroll
        for (int mp = 0; mp < 2; ++mp) s[mp][kt] = mfma16(k1, qf[mp][1], mfma16(k0, qf[mp][0], negm[mp]));
    }
    asm volatile("s_nop 15" : "+v"(s[0][0]), "+v"(s[0][1]), "+v"(s[0][2]), "+v"(s[0][3]), "+v"(s[1][0]), "+v"(s[1][1]), "+v"(s[1][2]), "+v"(s[1][3]));
    bf16x8 vfa[4], vfb[4];
    attn_vload(vfa, vb, 0, r, qq);
    float mxl[2];
#pragma unroll
    for (int mp = 0; mp < 2; ++mp) {
        float mx = max3f(s[mp][0][0], s[mp][0][1], s[mp][0][2]);
        mx = max3f(mx, s[mp][0][3], s[mp][1][0]); mx = max3f(mx, s[mp][1][1], s[mp][1][2]); mx = max3f(mx, s[mp][1][3], s[mp][2][0]);
        mx = max3f(mx, s[mp][2][1], s[mp][2][2]); mx = max3f(mx, s[mp][2][3], s[mp][3][0]); mx = max3f(mx, s[mp][3][1], s[mp][3][2]); mxl[mp] = max2f(mx, s[mp][3][3]);
    }
    if (first || __any(max2f(mxl[0], mxl[1]) > ATT_THR)) {
#pragma unroll
        for (int mp = 0; mp < 2; ++mp) {
            const float mx = xmax32a(xmax16a(mxl[mp]));
            const float dl = first ? mx : fmaxf(mx, 0.f);
            const float al = __builtin_amdgcn_exp2f(-dl); lrun[mp] *= al;
            negm[mp] = negm[mp] - dl;
#pragma unroll
            for (int c = 0; c < 8; ++c) O[mp][c] = O[mp][c] * al;
#pragma unroll
            for (int kt = 0; kt < 4; ++kt) s[mp][kt] = s[mp][kt] - dl;
        }
    }
#pragma unroll
    for (int mp = 0; mp < 2; ++mp) {
        float ps = 0.f;
#pragma unroll
        for (int kt = 0; kt < 4; ++kt)
#pragma unroll
            for (int j = 0; j < 4; ++j) { s[mp][kt][j] = __builtin_amdgcn_exp2f(s[mp][kt][j]); ps += s[mp][kt][j]; }
        lrun[mp] += ps;
#pragma unroll
        for (int u = 0; u < 2; ++u) {
            u32x4 w; w.x = cvt_pk_bf16(s[mp][2 * u][0], s[mp][2 * u][1]); w.y = cvt_pk_bf16(s[mp][2 * u][2], s[mp][2 * u][3]);
            w.z = cvt_pk_bf16(s[mp][2 * u + 1][0], s[mp][2 * u + 1][1]); w.w = cvt_pk_bf16(s[mp][2 * u + 1][2], s[mp][2 * u + 1][3]);
            pf[mp][u] = __builtin_bit_cast(bf16x8, w);
        }
    }
    if (do_store) {
        *(LAS u32x4*)kst = KR[0]; *(LAS u32x4*)(kst + 32 * ATT_KP) = KR[1]; *(LAS u32x4*)vst = VR[0]; *(LAS u32x4*)(vst + 64 * ATT_VP) = VR[1]; }
#define ATT_PV(VF, g) do { _Pragma("unroll") for (int i = 0; i < 4; ++i) { const int c = 2 * (g) + (i >> 1), u = i & 1; \
        O[0][c] = mfma16(VF[i], pf[0][u], O[0][c]); O[1][c] = mfma16(VF[i], pf[1][u], O[1][c]); } } while (0)
    __builtin_amdgcn_s_setprio(1);
    SCHED_FENCE(); attn_vload(vfb, vb, 1, r, qq); SCHED_FENCE(); ATT_PV(vfa, 0);
    SCHED_FENCE(); attn_vload(vfa, vb, 2, r, qq); SCHED_FENCE(); ATT_PV(vfb, 1);
    SCHED_FENCE(); attn_vload(vfb, vb, 3, r, qq); SCHED_FENCE(); ATT_PV(vfa, 2);
    SCHED_FENCE(); ATT_PV(vfb, 3); SCHED_FENCE();
    __builtin_amdgcn_s_setprio(0);
#undef ATT_PV
}
__device__ __forceinline__ void attn_unit(ldsp lds, bf16_t* U, const bf16_t* TT, const float* hg, float lam, float post, int h, int qrow0, int seg0, int n0, int seg1, int n1) {
    int tid = threadIdx.x; asm volatile("" : "+v"(tid)); const int lane = tid & 63, wv = tid >> 6, r = lane & 15, qq = lane >> 4;
    bf16x8 qf[2][2];
    const int mapw = __builtin_amdgcn_readfirstlane(wv >> 2), wq = wv & 3;
#pragma unroll
    for (int mp = 0; mp < 2; ++mp)
#pragma unroll
        for (int ks = 0; ks < 2; ++ks) qf[mp][ks] = *(const bf16x8*)(U + (size_t)(qrow0 + 32 * wq + 16 * mp + r) * LDU + U_DAQ + h * 128 + mapw * 64 + ks * 32 + qq * 8);
    f32x4 O[2][8]; f32x4 negm[2]; float lrun[2];
#pragma unroll
    for (int mp = 0; mp < 2; ++mp) { negm[mp] = (f32x4){0.f, 0.f, 0.f, 0.f}; lrun[mp] = 0.f;
#pragma unroll
        for (int c = 0; c < 8; ++c) O[mp][c] = (f32x4){0.f, 0.f, 0.f, 0.f}; }
    const int NT = n0 + n1;
    u32x4 kA[2], vA[2], kB[2], vB[2];
    const int krow_l = tid >> 4, kcv = tid & 15, vrow_l = tid >> 3, vcv = tid & 7;
    const bf16_t* kbase = U + (size_t)krow_l * LDU + U_DAK + h * 128 + kcv * 8;
    const bf16_t* vbase = TT + (size_t)(1024 + h * 128 + vrow_l) * LDT + vcv * 8;
#define ATT_LOAD(t, KR, VR) do { const int kr0 = (t) < n0 ? seg0 + 64 * (t) : seg1 + 64 * ((t) - n0); \
        KR[0] = *(const u32x4*)(kbase + (size_t)kr0 * LDU); KR[1] = *(const u32x4*)(kbase + (size_t)(kr0 + 32) * LDU); \
        VR[0] = *(const u32x4*)(vbase + kr0); VR[1] = *(const u32x4*)(vbase + (size_t)64 * LDT + kr0); } while (0)
#define ATT_STORE(buf, KR, VR) do { ldsp kb_ = lds + (buf) * ATT_BUF; ldsp vb_ = kb_ + ATT_KB; \
        *(LAS u32x4*)(kb_ + krow_l * ATT_KP + kcv * 16) = KR[0]; *(LAS u32x4*)(kb_ + (krow_l + 32) * ATT_KP + kcv * 16) = KR[1]; \
        *(LAS u32x4*)(vb_ + vrow_l * ATT_VP + vcv * 16) = VR[0]; *(LAS u32x4*)(vb_ + (vrow_l + 64) * ATT_VP + vcv * 16) = VR[1]; } while (0)
    __syncthreads();
    ATT_LOAD(0, kA, vA); ATT_LOAD(1, kB, vB); ATT_STORE(0, kA, vA); __syncthreads();
#pragma unroll 1
    for (int t = 0; t < NT; t += 2) {
        if (t + 2 < NT) ATT_LOAD(t + 2, kA, vA);
        attn_tile(lds, mapw, qf, O, negm, lrun, t == 0, r, qq, kB, vB, lds + ATT_BUF + krow_l * ATT_KP + kcv * 16, lds + ATT_BUF + ATT_KB + vrow_l * ATT_VP + vcv * 16, true);
        __syncthreads();
        if (t + 3 < NT) ATT_LOAD(t + 3, kB, vB);
        attn_tile(lds + ATT_BUF, mapw, qf, O, negm, lrun, false, r, qq, kA, vA, lds + krow_l * ATT_KP + kcv * 16, lds + ATT_KB + vrow_l * ATT_VP + vcv * 16, t + 2 < NT);
        __syncthreads();
    }
#undef ATT_LOAD
#undef ATT_STORE
    {
        LAS f32x4* X = (LAS f32x4*)lds;
#pragma unroll
        for (int rg = 0; rg < 2; ++rg) {
            const float l = xsum32(xsum16(lrun[rg]));
            const float sc = (mapw ? lam : 1.0f) / l;
#pragma unroll
            for (int c = 0; c < 8; ++c) { O[rg][c] = O[rg][c] * sc; if (mapw) X[((wq * 2 + rg) * 8 + c) * 64 + lane] = O[rg][c]; }
        }
        __syncthreads();
        if (mapw == 0) {
#pragma unroll
            for (int rg = 0; rg < 2; ++rg) {
                float ss = 0.f;
#pragma unroll
                for (int c = 0; c < 8; ++c) { O[rg][c] = O[rg][c] - X[((wq * 2 + rg) * 8 + c) * 64 + lane]; ss += (O[rg][c][0] * O[rg][c][0] + O[rg][c][1] * O[rg][c][1]) + (O[rg][c][2] * O[rg][c][2] + O[rg][c][3] * O[rg][c][3]); }
                ss = xsum32(xsum16(ss));
                const float rn = post / sqrtf(ss * (1.0f / 128.0f) + EPS);
                bf16_t* orow = U + (size_t)(qrow0 + 32 * wq + 16 * rg + r) * LDU + U_DAQ + h * 128;
#pragma unroll
                for (int c = 0; c < 8; ++c) { const f32x4 gg = *(const f32x4*)(hg + h * 128 + 16 * c + 4 * qq); const f32x4 y = O[rg][c] * rn * gg;
                    u32x2 w; w.x = cvt_pk_bf16(y[0], y[1]); w.y = cvt_pk_bf16(y[2], y[3]); *(u32x2*)(orow + 16 * c + 4 * qq) = w; }
            }
        }
    }
}

__device__ __forceinline__ float logsigmoidf_(float x) { return fminf(x, 0.f) - __logf(1.0f + __expf(-fabsf(x))); }
__device__ __forceinline__ void gate_scan(const float* G, int row0, int icol, int fcol, int dir, float m, int lane, LAS float* tg, LAS float* tM, LAS float* tb, float& b_end, float& M_end) {
    const int p0 = dir ? 127 - 2 * lane : 2 * lane, p1 = dir ? p0 - 1 : p0 + 1;
    const float f0 = G[(size_t)(row0 + p0) * 16 + fcol], f1 = G[(size_t)(row0 + p1) * 16 + fcol];
    const float i0 = G[(size_t)(row0 + p0) * 16 + icol], i1 = G[(size_t)(row0 + p1) * 16 + icol];
    const float lf0 = logsigmoidf_(f0), lf1 = logsigmoidf_(f1);
    float inc = lf0 + lf1;
#pragma unroll
    for (int o = 1; o < 64; o <<= 1) { const float t = __shfl_up(inc, o); if (lane >= o) inc += t; }
    float exc = __shfl_up(inc, 1); if (lane == 0) exc = 0.f;
    const float b0 = exc + lf0, b1 = b0 + lf1;
    const float g0 = i0 - b0, g1 = i1 - b1;
    float cm = fmaxf(g0, g1);
#pragma unroll
    for (int o = 1; o < 64; o <<= 1) { const float t = __shfl_up(cm, o); if (lane >= o) cm = fmaxf(cm, t); }
    float exm = __shfl_up(cm, 1); if (lane == 0) exm = -1e30f;
    const float G0 = fmaxf(exm, g0), G1 = fmaxf(G0, g1);
    const float M0 = fmaxf(m, G0), M1 = fmaxf(m, G1);
    tg[p0] = g0; tg[p1] = g1; tM[p0] = M0; tM[p1] = M1; tb[p0] = b0; tb[p1] = b1;
    b_end = __shfl(b1, 63); M_end = __shfl(M1, 63);
}
__device__ __forceinline__ int chunk_row0(int b, int dir, int s) {
    if (s < 2) return ML_ROWS + b * CTXL + 128 * (dir ? 1 - s : s);
    return b * SEQ + 128 * (dir ? 33 - s : s - 2);
}
__device__ __forceinline__ void mlstm_state_unit(ldsp lds, const bf16_t* KT, const bf16_t* TT, const float* G, bf16_t* CT, float* NST, float* MST, int chain, int j) {
    int tid = threadIdx.x; asm volatile("" : "+v"(tid)); const int lane = tid & 63, wv = tid >> 6, r = lane & 15, qq = lane >> 4;
    const int dir = chain & 1, bh = chain >> 1, b = bh >> 2, h = bh & 3;
    const int dvq = j >> 1, dkh = j & 1, wa = wv >> 2, wb = wv & 3; const bool nown = (dvq == 0) && (wa == 0);
    const int dv0 = 64 * dvq + 32 * wa, dk0w = 128 * dkh + 32 * wb;
    LAS float* tgs = (LAS float*)lds; LAS float* tend = tgs + NCH * 128; LAS float* tdm = tend + 2 * NCH + 4;
    ldsp stg = (ldsp)(tdm + 8 * 256) + wv * (32 * 80);
    const int icol = (dir ? 8 : 0) + h, fcol = (dir ? 12 : 4) + h;
    __syncthreads();
    for (int s = wv; s < NCH; s += 8) { float be, Me; gate_scan(G, chunk_row0(b, dir, s), icol, fcol, dir, -1e30f, lane, tgs + s * 128, tdm + wv * 256, tdm + wv * 256 + 128, be, Me);
        if (lane == 0) { tend[2 * s] = Me; tend[2 * s + 1] = be; } }
    __syncthreads();
    f32x4 acc[2][2];
#pragma unroll
    for (int a = 0; a < 2; ++a)
#pragma unroll
        for (int e = 0; e < 2; ++e) acc[a][e] = (f32x4){0.f, 0.f, 0.f, 0.f};
    float nval[2] = {0.f, 0.f}, m = 0.f;
    bf16x8 k0[2][2], v0[2][2], k1[2][2], v1[2][2], k2[2][2], v2[2][2], k3[2][2], v3[2][2];
    const bf16_t* kbase = KT + (size_t)(h * 256 + dk0w + r) * LDT + 8 * qq;
    const bf16_t* vbase = TT + (size_t)(h * 256 + dv0 + r) * LDT + 8 * qq;
#define M1_LOAD(KR, VR, s_, hf) do { const int row0_ = chunk_row0(b, dir, (s_)) + 64 * (hf); \
        _Pragma("unroll") for (int e = 0; e < 2; ++e) _Pragma("unroll") for (int ks = 0; ks < 2; ++ks) { \
            KR[e][ks] = *(const bf16x8*)(kbase + (size_t)(16 * e) * LDT + row0_ + 32 * ks); VR[e][ks] = *(const bf16x8*)(vbase + (size_t)(16 * e) * LDT + row0_ + 32 * ks); } } while (0)
    float Mend_ = 0.f, decay_ = 1.f, bend_ = 0.f, ns0_ = 0.f, ns1_ = 0.f;
#define M1_BEGIN(s_) do { \
        { _Pragma("unroll") for (int a = 0; a < 2; ++a) _Pragma("unroll") for (int e = 0; e < 2; ++e) _Pragma("unroll") for (int jj = 0; jj < 4; ++jj) \
              *(LAS bf16_t*)(stg + (16 * a + 4 * qq + jj) * 80 + (16 * e + r) * 2) = (bf16_t)(cvt_pk_bf16(acc[a][e][jj], 0.f) & 0xffffu); \
          if (nown) { if (qq == 0) { NST[(size_t)(chain * NCH + (s_)) * 256 + dk0w + r] = nval[0]; NST[(size_t)(chain * NCH + (s_)) * 256 + dk0w + 16 + r] = nval[1]; } if (j == 0 && tid == 0) MST[chain * NCH + (s_)] = m; } \
          asm volatile("s_waitcnt lgkmcnt(0)" ::: "memory"); \
          bf16_t* ct = CT + ((size_t)(chain * NCH + (s_))) * 65536 + (size_t)dv0 * 256 + dk0w; \
          _Pragma("unroll") for (int i = 0; i < 2; ++i) { const int pc_ = lane + 64 * i, row_ = pc_ >> 2, cv_ = pc_ & 3; \
              *(u32x4*)(ct + (size_t)row_ * 256 + cv_ * 8) = *(const LAS u32x4*)(stg + row_ * 80 + cv_ * 16); } } \
        const float Gend_ = tend[2 * (s_)]; bend_ = tend[2 * (s_) + 1]; Mend_ = fmaxf(m, Gend_); decay_ = __expf(m - Mend_); \
        _Pragma("unroll") for (int a = 0; a < 2; ++a) _Pragma("unroll") for (int e = 0; e < 2; ++e) acc[a][e] = acc[a][e] * decay_; \
        ns0_ = 0.f; ns1_ = 0.f; } while (0)
#define M1_HALF(KR, VR, s_, hf) do { \
        _Pragma("unroll") for (int ks = 0; ks < 2; ++ks) { \
            const f32x4 g0_ = *(const LAS f32x4*)(tgs + (s_) * 128 + 64 * (hf) + 32 * ks + 8 * qq), g1_ = *(const LAS f32x4*)(tgs + (s_) * 128 + 64 * (hf) + 32 * ks + 8 * qq + 4); \
            float w_[8]; _Pragma("unroll") for (int i = 0; i < 4; ++i) { w_[i] = __expf(g0_[i] - Mend_); w_[4 + i] = __expf(g1_[i] - Mend_); } \
            bf16x8 vw_[2]; \
            _Pragma("unroll") for (int a = 0; a < 2; ++a) { const u32x4 x_ = __builtin_bit_cast(u32x4, VR[a][ks]); const unsigned xs_[4] = {x_.x, x_.y, x_.z, x_.w}; u32x4 o_; unsigned os_[4]; \
                _Pragma("unroll") for (int i = 0; i < 4; ++i) os_[i] = cvt_pk_bf16(__uint_as_float(xs_[i] << 16) * w_[2 * i], __uint_as_float(xs_[i] & 0xffff0000u) * w_[2 * i + 1]); \
                o_.x = os_[0]; o_.y = os_[1]; o_.z = os_[2]; o_.w = os_[3]; vw_[a] = __builtin_bit_cast(bf16x8, o_); } \
            if (nown) { _Pragma("unroll") for (int e = 0; e < 2; ++e) { const u32x4 x_ = __builtin_bit_cast(u32x4, KR[e][ks]); const unsigned xs_[4] = {x_.x, x_.y, x_.z, x_.w}; float t_ = 0.f; \
                _Pragma("unroll") for (int i = 0; i < 4; ++i) t_ += __uint_as_float(xs_[i] << 16) * w_[2 * i] + __uint_as_float(xs_[i] & 0xffff0000u) * w_[2 * i + 1]; \
                if (e == 0) ns0_ += t_; else ns1_ += t_; } } \
            _Pragma("unroll") for (int e = 0; e < 2; ++e) _Pragma("unroll") for (int a = 0; a < 2; ++a) acc[a][e] = mfma16(vw_[a], KR[e][ks], acc[a][e]); } } while (0)
#define M1_END() do { \
        if (nown) { nval[0] = decay_ * nval[0] + xsum32(xsum16(ns0_)); nval[1] = decay_ * nval[1] + xsum32(xsum16(ns1_)); } \
        m = bend_ + Mend_; } while (0)
    M1_LOAD(k0, v0, 0, 0); M1_LOAD(k1, v1, 0, 1); M1_LOAD(k2, v2, 1, 0); M1_LOAD(k3, v3, 1, 1);
#pragma unroll 1
    for (int s = 0; s < NCH; s += 2) {
        M1_BEGIN(s);
        M1_HALF(k0, v0, s, 0); if (s + 2 < NCH) M1_LOAD(k0, v0, s + 2, 0);
        M1_HALF(k1, v1, s, 1); if (s + 2 < NCH) M1_LOAD(k1, v1, s + 2, 1);
        M1_END();
        M1_BEGIN(s + 1);
        M1_HALF(k2, v2, s + 1, 0); if (s + 3 < NCH) M1_LOAD(k2, v2, s + 3, 0);
        M1_HALF(k3, v3, s + 1, 1); if (s + 3 < NCH) M1_LOAD(k3, v3, s + 3, 1);
        M1_END();
    }
#undef M1_BEGIN
#undef M1_HALF
#undef M1_END
#undef M1_LOAD
}
__device__ __forceinline__ void mlstm_out_unit(ldsp lds, bf16_t* U, const bf16_t* TT, const float* G, const bf16_t* CT, const float* NST, const float* MST, const float* hg, int b, int h, int loc) {
    int tid = threadIdx.x; asm volatile("" : "+v"(tid)); const int lane = tid & 63, wv = tid >> 6, r = lane & 15, qq = lane >> 4;
    constexpr int QP = 544, PP = 288, QS = 0, KS = 128 * QP, TB = 2 * 128 * QP;
    LAS float* tgF = (LAS float*)(lds + TB); LAS float* tMF = tgF + 128; LAS float* tbF = tgF + 256;
    LAS float* tgB = tgF + 384; LAS float* tMB = tgF + 512; LAS float* tbB = tgF + 640;
    LAS float* tcf = tgF + 768; LAS float* tcb = tgF + 896; LAS float* tss = tgF + 1024;
    const int row0 = loc < 2 ? ML_ROWS + b * CTXL + 128 * loc : b * SEQ + 128 * (loc - 2);
    const int sF = loc, sB = loc < 2 ? 1 - loc : 35 - loc;
    const int chF = ((b * 4 + h) * 2), chB = chF + 1;
    const float mF = MST[chF * NCH + sF], mB = MST[chB * NCH + sB];
    __syncthreads();
#pragma unroll
    for (int i = 0; i < 8; ++i) { const int v = tid + 512 * i, row = v >> 5, cv = v & 31;
        *(LAS u32x4*)(lds + QS + row * QP + cv * 16) = *(const u32x4*)(U + (size_t)(row0 + row) * LDU + U_MLQ + h * 256 + cv * 8);
        *(LAS u32x4*)(lds + KS + row * QP + cv * 16) = *(const u32x4*)(U + (size_t)(row0 + row) * LDU + U_MLK + h * 256 + cv * 8); }
    LAS bf16_t* tn = (LAS bf16_t*)(tss + 1024);
    if (wv == 2) { const int d = lane >> 5, pc = lane & 31; const float* np = NST + (size_t)(d ? chB * NCH + sB : chF * NCH + sF) * 256 + 8 * pc;
        *(LAS u32x4*)(tn + d * 256 + 8 * pc) = pack8(*(const f32x4*)np, *(const f32x4*)(np + 4)); }
    if (wv == 0) { float be, Me; gate_scan(G, row0, h, 4 + h, 0, mF, lane, tgF, tMF, tbF, be, Me); }
    if (wv == 1) { float be, Me; gate_scan(G, row0, 8 + h, 12 + h, 1, mB, lane, tgB, tMB, tbB, be, Me); }
    __syncthreads();
    {
        const int p = 16 * wv + r;
        f32x4 S[8], Sn = (f32x4){0.f, 0.f, 0.f, 0.f};
#pragma unroll
        for (int ct = 0; ct < 8; ++ct) S[ct] = (f32x4){0.f, 0.f, 0.f, 0.f};
#pragma unroll 2
        for (int ks = 0; ks < 8; ++ks) {
            const bf16x8 qv = *(const LAS bf16x8*)(lds + QS + p * QP + (32 * ks + 8 * qq) * 2);
#pragma unroll
            for (int ct = 0; ct < 8; ++ct) S[ct] = mfma16(*(const LAS bf16x8*)(lds + KS + (16 * ct + r) * QP + (32 * ks + 8 * qq) * 2), qv, S[ct]);
            u32x4 w = *(const LAS u32x4*)(tn + (r & 1) * 256 + 32 * ks + 8 * qq);
            if (r >= 2) w = (u32x4){0u, 0u, 0u, 0u};
            Sn = mfma16(__builtin_bit_cast(bf16x8, w), qv, Sn);
        }
        const float qnF = __shfl(Sn[0], r), qnB = __shfl(Sn[1], r);
        const float MFp = tMF[p], MBp = tMB[p];
        float sumF = 0.f, sumB = 0.f;
#pragma unroll
        for (int ct = 0; ct < 8; ++ct)
#pragma unroll
            for (int jj = 0; jj < 4; ++jj) { const int sg = 16 * ct + 4 * qq + jj;
                const float ef = sg <= p ? __expf(tgF[sg] - MFp) : 0.f, eb = sg >= p ? __expf(tgB[sg] - MBp) : 0.f;
                sumF += ef * S[ct][jj]; sumB += eb * S[ct][jj]; }
        sumF += __shfl_xor(sumF, 16); sumF += __shfl_xor(sumF, 32); sumB += __shfl_xor(sumB, 16); sumB += __shfl_xor(sumB, 32);
        const float scF = __expf(mF - MFp), scB = __expf(mB - MBp);
        const float denF = scF * qnF + sumF, denB = scB * qnB + sumB;
        const float rF = 1.0f / fmaxf(fabsf(denF), __expf(-(tbF[p] + MFp))), rB = 1.0f / fmaxf(fabsf(denB), __expf(-(tbB[p] + MBp)));
        if (qq == 0) { tcf[p] = scF * rF; tcb[p] = scB * rB; }
#pragma unroll
        for (int ct = 0; ct < 8; ++ct)
#pragma unroll
            for (int jj = 0; jj < 4; ++jj) { const int sg = 16 * ct + 4 * qq + jj;
                const float ef = sg <= p ? __expf(tgF[sg] - MFp) : 0.f, eb = sg >= p ? __expf(tgB[sg] - MBp) : 0.f;
                S[ct][jj] *= (ef * rF + eb * rB); }
        __syncthreads();
#pragma unroll
        for (int ct = 0; ct < 8; ++ct) {
            u32x2 w; w.x = cvt_pk_bf16(S[ct][0], S[ct][1]); w.y = cvt_pk_bf16(S[ct][2], S[ct][3]);
            *(LAS u32x2*)(lds + KS + p * PP + (16 * ct + 4 * qq) * 2) = w; }
    }
    __syncthreads();
    f32x4 O[2][8];
#pragma unroll
    for (int a = 0; a < 2; ++a)
#pragma unroll
        for (int tt = 0; tt < 8; ++tt) O[a][tt] = (f32x4){0.f, 0.f, 0.f, 0.f};
    bf16x8 cfA[8], cfB[8];
#define M2_CF(CF, pass_) do { const bf16_t* ct_ = CT + (size_t)(((pass_) & 1) ? chB * NCH + sB : chF * NCH + sF) * 65536 + (size_t)(32 * wv + 16 * ((pass_) >> 1) + r) * 256 + 8 * qq; \
        _Pragma("unroll") for (int ks = 0; ks < 8; ++ks) CF[ks] = *(const bf16x8*)(ct_ + 32 * ks); } while (0)
#define M2_PASS(CF, pass_) do { f32x4 T[8]; \
        _Pragma("unroll") for (int tt = 0; tt < 8; ++tt) T[tt] = (f32x4){0.f, 0.f, 0.f, 0.f}; \
        _Pragma("unroll") for (int ks = 0; ks < 8; ++ks) { \
            _Pragma("unroll") for (int tt = 0; tt < 8; ++tt) T[tt] = mfma16(CF[ks], *(const LAS bf16x8*)(lds + QS + (16 * tt + r) * QP + (32 * ks + 8 * qq) * 2), T[tt]); \
            SCHED_FENCE(); } \
        LAS float* tc_ = ((pass_) & 1) ? tcb : tcf; \
        _Pragma("unroll") for (int tt = 0; tt < 8; ++tt) O[(pass_) >> 1][tt] = O[(pass_) >> 1][tt] + T[tt] * tc_[16 * tt + r]; } while (0)
    bf16x8 vf[2][4];
    M2_CF(cfA, 0);
    M2_CF(cfB, 1); M2_PASS(cfA, 0);
    M2_CF(cfA, 2); M2_PASS(cfB, 1);
    M2_CF(cfB, 3); M2_PASS(cfA, 2);
#pragma unroll
    for (int a = 0; a < 2; ++a)
#pragma unroll
        for (int u = 0; u < 4; ++u) vf[a][u] = *(const bf16x8*)(TT + (size_t)(h * 256 + 32 * wv + 16 * a + r) * LDT + row0 + 32 * u + 8 * qq);
    M2_PASS(cfB, 3);
#undef M2_CF
#undef M2_PASS
    {
#pragma unroll
        for (int u = 0; u < 4; ++u) {
#pragma unroll
            for (int tt = 0; tt < 8; ++tt) { const bf16x8 pv = *(const LAS bf16x8*)(lds + KS + (16 * tt + r) * PP + (32 * u + 8 * qq) * 2);
                O[0][tt] = mfma16(vf[0][u], pv, O[0][tt]); O[1][tt] = mfma16(vf[1][u], pv, O[1][tt]); }
            SCHED_FENCE();
        }
    }
#pragma unroll
    for (int tt = 0; tt < 8; ++tt) { float ss = 0.f;
#pragma unroll
        for (int a = 0; a < 2; ++a) ss += (O[a][tt][0] * O[a][tt][0] + O[a][tt][1] * O[a][tt][1]) + (O[a][tt][2] * O[a][tt][2] + O[a][tt][3] * O[a][tt][3]);
        ss += __shfl_xor(ss, 16); ss += __shfl_xor(ss, 32);
        if (qq == 0) tss[wv * 128 + 16 * tt + r] = ss; }
    __syncthreads();
#pragma unroll
    for (int tt = 0; tt < 8; ++tt) { const int p = 16 * tt + r; float ss = 0.f;
#pragma unroll
        for (int w = 0; w < 8; ++w) ss += tss[w * 128 + p];
        const float rn = 1.0f / sqrtf(ss * (1.0f / 256.0f) + EPS);
#pragma unroll
        for (int a = 0; a < 2; ++a) { const int dv = 32 * wv + 16 * a + 4 * qq;
            bf16_t* op = U + (size_t)(row0 + p) * LDU + U_OG + h * 256 + dv;
            const u32x2 gw = *(const u32x2*)op; const f32x4 gg = *(const f32x4*)(hg + h * 256 + dv);
            f32x4 y = O[a][tt] * rn * gg;
            y[0] *= __uint_as_float(gw.x << 16); y[1] *= __uint_as_float(gw.x & 0xffff0000u); y[2] *= __uint_as_float(gw.y << 16); y[3] *= __uint_as_float(gw.y & 0xffff0000u);
            u32x2 w; w.x = cvt_pk_bf16(y[0], y[1]); w.y = cvt_pk_bf16(y[2], y[3]); *(u32x2*)op = w; }
    }
}


#define XB_TMO      128
#define XB_XCNT(j)  (256  + 64 * (j))
#define XB_XSUB(j)  (1280 + 64 * (j))
#define XB_XGEN(j)  (2304 + 64 * (j))
#define XB_TOP      3328
#define XB_TOPGEN   3392
#define XCD_BAR_WORDS 3456
#define XB_SPIN_CAP (1u << 18)
__device__ __forceinline__ unsigned xb_ld(unsigned* p)              { return __hip_atomic_load(p, __ATOMIC_RELAXED, __HIP_MEMORY_SCOPE_AGENT); }
__device__ __forceinline__ unsigned xb_add(unsigned* p, unsigned v) { return __hip_atomic_fetch_add(p, v, __ATOMIC_RELAXED, __HIP_MEMORY_SCOPE_AGENT); }
__device__ __forceinline__ unsigned xb_xcc_id() { return (unsigned)__builtin_amdgcn_s_getreg((3 << 11) | 20) & 0xFu; }
#define XB_SPIN(cond, bar) do { unsigned _sp = 0; while (cond) { __builtin_amdgcn_s_sleep(1); \
    if ((++_sp & 255u) == 0u) { if (xb_ld(&(bar)[XB_TMO])) break; if (_sp > XB_SPIN_CAP) { atomicAdd(&(bar)[XB_TMO], 1u); break; } } } } while (0)
struct XcdBarrier { unsigned* bar; unsigned x; volatile LAS unsigned* st; };
__device__ __forceinline__ XcdBarrier xcd_barrier_post(unsigned* bar, volatile LAS unsigned* st) {
    XcdBarrier b; b.bar = bar; b.x = xb_xcc_id(); b.st = st;
    if (threadIdx.x == 0) (void)xb_add(&bar[XB_XCNT(b.x)], 1u);
    return b;
}
__device__ __forceinline__ void xcd_barrier_complete(unsigned* bar, unsigned x, unsigned& nloc, unsigned& nx) {
    const unsigned G = gridDim.x * gridDim.y * gridDim.z;
    unsigned sum, cnt, mine, sp = 0u;
    for (;;) {
        sum = 0u; cnt = 0u; mine = 0u;
#pragma unroll
        for (unsigned j = 0; j < 16; ++j) { const unsigned c = xb_ld(&bar[XB_XCNT(j)]); sum += c; cnt += (c > 0u) ? 1u : 0u; mine = (j == x) ? c : mine; }
        if (sum == G) break;
        __builtin_amdgcn_s_sleep(1);
        if ((++sp & 255u) == 0u) { if (xb_ld(&bar[XB_TMO])) break; if (sp > XB_SPIN_CAP) { atomicAdd(&bar[XB_TMO], 1u); break; } }
    }
    nloc = mine > 0u ? mine : 1u; nx = cnt > 0u ? cnt : 1u;
}
__device__ __forceinline__ void xcd_barrier(const XcdBarrier& b) {
    asm volatile("s_waitcnt vmcnt(0)" ::: "memory");
    __syncthreads();
    if (threadIdx.x == 0) {
        unsigned* bar = b.bar;
        __builtin_amdgcn_s_waitcnt(0);
        unsigned nloc = b.st[0], nx = b.st[1];
        if (nloc == 0u) { xcd_barrier_complete(bar, b.x, nloc, nx); b.st[0] = nloc; b.st[1] = nx; }
        const unsigned old = xb_add(&bar[XB_XSUB(b.x)], 1u);
        const unsigned gen = old / nloc;
        if (old + 1u == (gen + 1u) * nloc) {
            __builtin_amdgcn_fence(__ATOMIC_RELEASE, "agent");
            asm volatile("s_waitcnt vmcnt(0)" ::: "memory");
            const unsigned og = xb_add(&bar[XB_TOP], 1u);
            const unsigned tg = og / nx;
            if (og + 1u == (tg + 1u) * nx) xb_add(&bar[XB_TOPGEN], 1u);
            else XB_SPIN(xb_ld(&bar[XB_TOPGEN]) == tg, bar);
            __builtin_amdgcn_fence(__ATOMIC_ACQUIRE, "agent");
            xb_add(&bar[XB_XGEN(b.x)], 1u);
            asm volatile("s_waitcnt vmcnt(0)" ::: "memory");
        } else {
            XB_SPIN(xb_ld(&bar[XB_XGEN(b.x)]) == gen, bar);
            __builtin_amdgcn_fence(__ATOMIC_ACQUIRE, "agent");
            asm volatile("s_waitcnt vmcnt(0)" ::: "memory");
        }
    }
    __syncthreads();
}

struct Params {
    const float *x, *c, *ctx, *c_ctx, *w_ada, *b_ada, *norm_g, *w_in, *ml_gate_b, *ml_head_g, *da_lam, *da_head_g, *w_br_ml, *w_br_da, *w_br_fn, *w_out, *w_ffn_in, *w_ffn_out, *final_g;
    float* out; unsigned char* ws;
};

struct WSeg { const float* W; int ldn, off, width, K; bf16_t* dst; int Kd, row_off, perm, nitems; };
__device__ __forceinline__ WSeg wseg(const Params& P, int l, int s) {
    WSeg g; unsigned char* ws = P.ws;
    const float* win = P.w_in + (size_t)l * DM * DIN; bf16_t* WIN = (bf16_t*)(ws + WS_WIN);
    g.ldn = DIN; g.K = DM; g.Kd = DM; g.perm = 0; g.width = 1024; g.W = win; g.dst = WIN; g.off = 0; g.row_off = 0;
    switch (s) {
        case 0: g.off = 0;    g.row_off = 7424; break;
        case 1: g.off = 1024; g.row_off = 8448; break;
        case 2: g.off = 2048; g.row_off = 9472; break;
        case 3: g.off = 3072; g.row_off = 6400; break;
        case 4: g.off = 4096; g.row_off = 0; g.width = 16; break;
        case 5: g.off = 4112; g.row_off = 5376; g.perm = 1; break;
        case 6: g.off = 5136; g.row_off = 4352; g.perm = 1; break;
        case 7: g.off = 6160; g.row_off = 10496; break;
        case 8: g.off = 7184; g.row_off = 3328; break;
        case 9: g.off = 8208; g.row_off = 256; g.width = 3072; break;
        case 10: g.W = P.w_br_ml + (size_t)l * DM * DM; g.ldn = DM; g.dst = (bf16_t*)(ws + WS_WBR); break;
        case 11: g.W = P.w_br_da + (size_t)l * DM * DM; g.ldn = DM; g.dst = (bf16_t*)(ws + WS_WBR) + (size_t)DM * DM; break;
        case 12: g.W = P.w_br_fn + (size_t)l * DM * DM; g.ldn = DM; g.dst = (bf16_t*)(ws + WS_WBR) + (size_t)2 * DM * DM; break;
        case 13: g.W = P.w_out + (size_t)l * DM * DM; g.ldn = DM; g.dst = (bf16_t*)(ws + WS_WOUT); break;
        case 14: g.W = P.w_ffn_in + (size_t)l * DM * 2 * DFF; g.ldn = 2 * DFF; g.width = 2 * DFF; g.dst = (bf16_t*)(ws + WS_WF1); g.perm = 2; break;
        default: g.W = P.w_ffn_out + (size_t)l * DFF * DM; g.ldn = DM; g.K = DFF; g.Kd = DFF; g.dst = (bf16_t*)(ws + WS_WF2); break;
    }
    g.nitems = (g.K / 64) * ((g.width + 31) / 32);
    return g;
}


__device__ __forceinline__ void convert_dynamic(const Params& P, ldsp lds, int lw, int s_lo, int s_hi, unsigned* ctr, int max_grabs = 1 << 30) {
    int tid = threadIdx.x; asm volatile("" : "+v"(tid)); const int lane = tid & 63, wv = tid >> 6;
    LAS float* scr = (LAS float*)(lds + wv * 8448); LAS unsigned* slot = (LAS unsigned*)(lds + 8 * 8448);
    int total = 0;
    for (int sg = s_lo; sg < s_hi; ++sg) total += wseg(P, lw, sg).nitems;
    __syncthreads();
    for (int gcount = 0; gcount < max_grabs; ++gcount) {
        if (tid == 0) *slot = atomicAdd(ctr, 8u);
        __syncthreads();
        const int base = (int)*slot;
        __syncthreads();
        if (base >= total) break;
        int it = base + wv;
        if (it < total) {
            int sg = s_lo; WSeg g = wseg(P, lw, sg);
            while (it >= g.nitems) { it -= g.nitems; ++sg; g = wseg(P, lw, sg); }
            const int nbk = (g.width + 31) / 32;
            transpose_item(g.W, g.ldn, g.off, g.width, g.dst, g.Kd, g.row_off, g.perm, scr, it / nbk, it % nbk, lane);
        }
    }
}

__global__ void __launch_bounds__(512, 2) fwd_megakernel(Params P) {
    extern __shared__ __attribute__((aligned(16))) unsigned char lds_raw[];
    cg::grid_group grid = cg::this_grid();
    ldsp lds = (ldsp)lds_raw;
    int tid = threadIdx.x; asm volatile("" : "+v"(tid)); const int G = gridDim.x, bx = blockIdx.x;
    const int vcu = (G % 8 == 0) ? (bx % 8) * (G / 8) + bx / 8 : bx;
    const int NGW = G * 8;
    const int gt = bx * 512 + tid, NGT = G * 512;
    volatile LAS unsigned* xst = (volatile LAS unsigned*)(lds + LDS_BYTES - 16);
    if (threadIdx.x < 4) xst[threadIdx.x] = 0u;
    __syncthreads();
    const XcdBarrier xbar = xcd_barrier_post((unsigned*)(P.ws + WS_BAR), xst);
    {
    unsigned char* ws = P.ws; asm volatile("" : "+s"(ws));
    bf16_t* U = (bf16_t*)(ws + WS_U); bf16_t* TT = (bf16_t*)(ws + WS_TT); float* XC = (float*)(ws + WS_XC); bf16_t* AB = (bf16_t*)(ws + WS_AB);
    bf16_t* AT = (bf16_t*)(ws + WS_AB); bf16_t* KT = (bf16_t*)(ws + WS_KT); bf16_t* ATC = (bf16_t*)(ws + WS_ATC); bf16_t* Dm = (bf16_t*)(ws + WS_D); bf16_t* Dc = (bf16_t*)(ws + WS_DC); bf16_t* Wc = (bf16_t*)(ws + WS_WC);
    float* ROPE = (float*)(ws + WS_ROPE); float* MODS = (float*)(ws + WS_MODS); float* GG = (float*)(ws + WS_G); float* NST = (float*)(ws + WS_NST); float* MST = (float*)(ws + WS_MST);
    unsigned* CTR = (unsigned*)(ws + WS_CTR); bf16_t* CT = (bf16_t*)(ws + WS_CT); float* Y = (float*)(ws + WS_CT); float* YC = (float*)(ws + WS_CT + 72 * MiB); float* TP6 = (float*)(ws + WS_CT); float* TP9 = (float*)(ws + WS_CT + 4 * MiB); bf16_t* HID = (bf16_t*)(ws + WS_U);
    bf16_t* WIN = (bf16_t*)(ws + WS_WIN); bf16_t* WBR = (bf16_t*)(ws + WS_WBR); bf16_t* WOUT = (bf16_t*)(ws + WS_WOUT); bf16_t* WF1 = (bf16_t*)(ws + WS_WF1); bf16_t* WF2 = (bf16_t*)(ws + WS_WF2);

        for (int v = gt; v < 4096 * 512; v += NGT) { const int tp = v >> 9, k0 = (v & 511) * 8; float e[8];
#pragma unroll
            for (int j = 0; j < 8; ++j) { const int k = k0 + j; const float a = (float)((k * tp) & 4095) * (1.0f / 2048.0f); e[j] = (k <= 2048 ? cospif(a) : -sinpif(a)) * (1.0f / 64.0f); }
            u32x4 w; w.x = cvt_pk_bf16(e[0], e[1]); w.y = cvt_pk_bf16(e[2], e[3]); w.z = cvt_pk_bf16(e[4], e[5]); w.w = cvt_pk_bf16(e[6], e[7]);
            *(u32x4*)(Dm + (size_t)tp * 4096 + k0) = w; }
        for (int v = gt; v < 256 * 512; v += NGT) {
            { const int tp = v >> 9, k = v & 511, ri = k >> 8, t = k & 255; const float a = (float)((t * tp) & 255) * (1.0f / 128.0f);
              Dc[v] = (bf16_t)(cvt_pk_bf16((ri ? sinpif(a) : cospif(a)) * (1.0f / 16.0f), 0.f) & 0xffffu); }
            { const int row = v >> 8, c = v & 255, ri = row >> 8, cp = row & 255; const float a = (float)((c * cp) & 255) * (1.0f / 128.0f);
              Wc[v] = (bf16_t)(cvt_pk_bf16((ri ? -sinpif(a) : cospif(a)) * (1.0f / 16.0f), 0.f) & 0xffffu); }
        }
        for (int v = gt; v < 4096 * 32; v += NGT) { const int t = v >> 5, i = v & 31; const float pos = (float)(i < 16 ? (t >> 6) : (t & 63));
            const float inv = powf(10000.0f, -(float)(i & 15) * (1.0f / 16.0f)); const float ang = pos * inv; ROPE[2 * v] = cosf(ang); ROPE[2 * v + 1] = sinf(ang); }
        LAS float* sl = (LAS float*)lds; LAS float* red = sl + 5 * 1024;
        for (int i = tid; i < 5 * 1024; i += 512) { const float cvv = i < 4096 ? P.c[i] : P.c_ctx[i - 4096]; sl[i] = cvv * sigmoidf_(cvv); }
        __syncthreads();
        for (int it = bx; it < DEPTH * 192; it += G) {
            const int l = it / 192, n0 = (it % 192) * 32, col = tid & 31, ksg = tid >> 5;
            const float* W = P.w_ada + (size_t)l * DM * 6144 + n0 + col;
            float a[5] = {0.f, 0.f, 0.f, 0.f, 0.f};
#pragma unroll 8
            for (int kk = 0; kk < 64; ++kk) { const int k = ksg * 64 + kk; const float w = W[(size_t)k * 6144];
#pragma unroll
                for (int s = 0; s < 5; ++s) a[s] += sl[s * 1024 + k] * w; }
#pragma unroll
            for (int s = 0; s < 5; ++s) red[(ksg * 5 + s) * 32 + col] = a[s];
            __syncthreads();
            if (tid < 160) { const int s = tid >> 5, cc = tid & 31; float sum = 0.f;
#pragma unroll
                for (int q = 0; q < 16; ++q) sum += red[(q * 5 + s) * 32 + cc];
                MODS[(size_t)(l * 5 + s) * 6144 + n0 + cc] = sum + P.b_ada[(size_t)l * 6144 + n0 + cc]; }
            __syncthreads();
        }
    }
    grid.sync();

#pragma unroll 1
    for (int l = 0; l < DEPTH; ++l) {
        int tidl = threadIdx.x; asm volatile("" : "+v"(tidl));
        const int lane = tidl & 63, wv = tidl >> 6, gw = bx * 8 + wv;
    unsigned char* ws = P.ws; asm volatile("" : "+s"(ws));
    bf16_t* U = (bf16_t*)(ws + WS_U); bf16_t* TT = (bf16_t*)(ws + WS_TT); float* XC = (float*)(ws + WS_XC); bf16_t* AB = (bf16_t*)(ws + WS_AB);
    bf16_t* AT = (bf16_t*)(ws + WS_AB); bf16_t* KT = (bf16_t*)(ws + WS_KT); bf16_t* ATC = (bf16_t*)(ws + WS_ATC); bf16_t* Dm = (bf16_t*)(ws + WS_D); bf16_t* Dc = (bf16_t*)(ws + WS_DC); bf16_t* Wc = (bf16_t*)(ws + WS_WC);
    float* ROPE = (float*)(ws + WS_ROPE); float* MODS = (float*)(ws + WS_MODS); float* GG = (float*)(ws + WS_G); float* NST = (float*)(ws + WS_NST); float* MST = (float*)(ws + WS_MST);
    unsigned* CTR = (unsigned*)(ws + WS_CTR); bf16_t* CT = (bf16_t*)(ws + WS_CT); float* Y = (float*)(ws + WS_CT); float* YC = (float*)(ws + WS_CT + 72 * MiB); float* TP6 = (float*)(ws + WS_CT); float* TP9 = (float*)(ws + WS_CT + 4 * MiB); bf16_t* HID = (bf16_t*)(ws + WS_U);
    bf16_t* WIN = (bf16_t*)(ws + WS_WIN); bf16_t* WBR = (bf16_t*)(ws + WS_WBR); bf16_t* WOUT = (bf16_t*)(ws + WS_WOUT); bf16_t* WF1 = (bf16_t*)(ws + WS_WF1); bf16_t* WF2 = (bf16_t*)(ws + WS_WF2);

        const bool need_ctx = l < DEPTH - 1;
        const float lam_init = 0.8f - 0.6f * expf(-0.3f * (float)l);
        const float* srcL = l == 0 ? P.x : P.out; const float* srcC = l == 0 ? P.ctx : XC;
        const float* mods = MODS + (size_t)l * 5 * 6144;
        const int nMr = need_ctx ? 68 : 64;
        {
            LAS float* scr = (LAS float*)(lds + wv * 8448);
            int base = 0;
            for (int s = (l == 0 ? 0 : 15); s < 16; ++s) { const WSeg g = wseg(P, l, s); const int nbk = (g.width + 31) / 32;
                int it = gw - (base % NGW); if (it < 0) it += NGW;
                for (; it < g.nitems; it += NGW) transpose_item(g.W, g.ldn, g.off, g.width, g.dst, g.Kd, g.row_off, g.perm, scr, it / nbk, it % nbk, lane);
                base += g.nitems; }
            for (int row = gw; row < MROWS; row += NGW) { const bool lat = row < ML_ROWS; const int s = lat ? row >> 12 : 4;
                const float* xr = lat ? srcL + (size_t)row * DM : srcC + (size_t)(row - ML_ROWS) * DM;
                if (lat || l == 0) norm_mod_row(xr, P.norm_g + (size_t)(l * 2) * DM, mods + s * 6144, mods + s * 6144 + 1024, AB + (size_t)row * DM, lane);
                else norm_mod_row(xr, P.norm_g + (size_t)(l * 2) * DM, mods + s * 6144, mods + s * 6144 + 1024, AB + (size_t)row * DM, lane, TP9 + (size_t)(row - ML_ROWS) * DM, XC + (size_t)(row - ML_ROWS) * DM);
                if (l == 0 && !lat) {
#pragma unroll
                    for (int j = 0; j < 4; ++j) *(f32x4*)(XC + (size_t)(row - ML_ROWS) * DM + 4 * lane + 256 * j) = *(const f32x4*)(xr + 4 * lane + 256 * j); } }
        }
        xcd_barrier(xbar);
        {
            pg8::Sched S; S.init(AB, WIN, DM, DM, 68, 37, 1, 1, 0, 0, 0, 0, G, bx, true);
            EpiInproj E{U, GG, P.ml_gate_b + l * 16, ROPE};
            pg8::gemm_phase(lds, pg8::Gemm{DM, DM, DM}, S, E);
            pg8::Sched S2; S2.init(WIN + (size_t)8448 * DM, AB, DM, DM, 12, 68, 1, 1, 0, 0, 0, 0, G, bx, true);
            EpiTT E2{TT, KT};
            pg8::gemm_phase(lds, pg8::Gemm{DM, DM, DM}, S2, E2);
        }
        xcd_barrier(xbar);
        {
            {
                int tf = threadIdx.x; asm volatile("" : "+v"(tf)); const int lf = tf & 63, gwf = bx * 8 + (tf >> 6);
                for (int pr = gwf; pr < NB * 2047; pr += 2 * NGW) {
                    const int pr2 = pr + NGW; const bool ok2 = pr2 < NB * 2047; const int q2 = ok2 ? pr2 : pr;
                    const int b1 = pr / 2047, t1 = pr - b1 * 2047 + 1, b2 = q2 / 2047, t2 = q2 - b2 * 2047 + 1;
                    bf16_t* ra1 = U + (size_t)(b1 * SEQ + t1) * LDU + U_FN + lf * 16; bf16_t* rb1 = U + (size_t)(b1 * SEQ + SEQ - t1) * LDU + U_FN + lf * 16;
                    bf16_t* ra2 = U + (size_t)(b2 * SEQ + t2) * LDU + U_FN + lf * 16; bf16_t* rb2 = U + (size_t)(b2 * SEQ + SEQ - t2) * LDU + U_FN + lf * 16;
                    u32x4 xa[2][2], xb[2][2];
#pragma unroll
                    for (int i = 0; i < 2; ++i) { xa[0][i] = *(const u32x4*)(ra1 + 8 * i); xb[0][i] = *(const u32x4*)(rb1 + 8 * i); xa[1][i] = *(const u32x4*)(ra2 + 8 * i); xb[1][i] = *(const u32x4*)(rb2 + 8 * i); }
#pragma unroll
                    for (int q = 0; q < 2; ++q) { if (q == 1 && !ok2) break; bf16_t* ra = q ? ra2 : ra1; bf16_t* rb = q ? rb2 : rb1;
#pragma unroll
                        for (int i = 0; i < 2; ++i) {
                            const unsigned a4[4] = {xa[q][i].x, xa[q][i].y, xa[q][i].z, xa[q][i].w}, b4[4] = {xb[q][i].x, xb[q][i].y, xb[q][i].z, xb[q][i].w}; unsigned p4[4], m4[4];
#pragma unroll
                            for (int e = 0; e < 4; ++e) { const float al = __uint_as_float(a4[e] << 16), ah = __uint_as_float(a4[e] & 0xffff0000u), bl = __uint_as_float(b4[e] << 16), bh = __uint_as_float(b4[e] & 0xffff0000u);
                                p4[e] = cvt_pk_bf16(al + bl, ah + bh); m4[e] = cvt_pk_bf16(al - bl, ah - bh); }
                            *(u32x4*)(ra + 8 * i) = (u32x4){p4[0], p4[1], p4[2], p4[3]}; *(u32x4*)(rb + 8 * i) = (u32x4){m4[0], m4[1], m4[2], m4[3]}; } }
                }
            }
            for (int u = vcu; u < 256; u += G) mlstm_state_unit(lds, KT, TT, GG, CT, NST, MST, u >> 3, u & 7);
            float lam;
            { const float* lq = P.da_lam + (size_t)l * 256; float s1 = 0.f, s2 = 0.f;
              for (int i = 0; i < 64; ++i) { s1 += lq[i] * lq[64 + i]; s2 += lq[128 + i] * lq[192 + i]; }
              lam = expf(s1) - expf(s2) + lam_init; }
            const int natt = need_ctx ? 1088 : 1024;
            for (int a = vcu; a < natt; a += G) {
                if (a < 1024) { const int bh = a >> 5, qb = a & 31, b = bh >> 3, h = bh & 7;
                    attn_unit(lds, U, TT, P.da_head_g + (size_t)l * DM, lam, 1.0f - lam_init, h, b * SEQ + 128 * qb, b * SEQ, 64, ML_ROWS + b * CTXL, 4); }
                else { const int bh = (a - 1024) >> 1, hf = a & 1, b = bh >> 3, h = bh & 7;
                    attn_unit(lds, U, TT, P.da_head_g + (size_t)l * DM, lam, 1.0f - lam_init, h, ML_ROWS + b * CTXL + 128 * hf, ML_ROWS + b * CTXL, 4, 0, 0); }
            }
        }
        xcd_barrier(xbar);
        {
            const int nm2 = need_ctx ? 16 * NCH : 16 * 32;
            for (int u = vcu; u < nm2; u += G) { const int bh = need_ctx ? u / NCH : u >> 5, loc = need_ctx ? u % NCH : 2 + (u & 31); mlstm_out_unit(lds, U, TT, GG, CT, NST, MST, P.ml_head_g + (size_t)l * DM, bh >> 2, bh & 3, loc); }
            __syncthreads();
            {
                const int f1c = (G == 256 && need_ctx) ? ((bx & 7) ? bx - (bx >> 3) - 1 : 224 + (bx >> 3) + 48) : bx;
                pg8::Sched S; S.init(Wc, U + U_FN, 256, LDU, 2, 16, 16, 4, 0, 0, (size_t)SEQ * LDU * 2, 512, (G == 256 && need_ctx) ? 224 : G, f1c, false);
                S.fold = true; S.nwg = 17 * 16;
                EpiF1Fold E{AT};
                pg8::gemm_phase(lds, pg8::Gemm{256, LDU, 256}, S, E);
            }
            if (need_ctx) {
                pg8::Sched S; S.init(Wc, U + (size_t)ML_ROWS * LDU + U_FN, 256, LDU, 2, 1, 16, 4, 0, 0, (size_t)CTXL * LDU * 2, 512, G, bx, false);
                EpiF1 E{ATC, CTXL};
                pg8::gemm_phase(lds, pg8::Gemm{256, LDU, 256}, S, E);
            }
            if (l + 1 < DEPTH && (G != 256 || (bx & 7))) convert_dynamic(P, lds, l + 1, 0, 10, CTR + 4 * l, 1);
        }
        xcd_barrier(xbar);
        {
            {
                pg8::Sched S; S.init(Dm, AT, 4096, 4096, 16, 4, 4, 1, 0, 0, (size_t)1024 * 4096 * 2, 0, G, bx, false);
                EpiF2 E{U, 0, SEQ};
                pg8::gemm_phase(lds, pg8::Gemm{4096, 4096, 4096}, S, E);
            }
            if (need_ctx) {
                pg8::Sched S; S.init(Dc, ATC, 512, 512, 1, 4, 4, 1, 0, 0, (size_t)1024 * 512 * 2, 0, G, bx, false);
                EpiF2 E{U, ML_ROWS, CTXL};
                pg8::gemm_phase(lds, pg8::Gemm{512, 512, 512}, S, E);
            }
        }
        xcd_barrier(xbar);
        {
            { pg8::Sched S; S.init(U + U_OG, WBR, LDU, DM, 64, 4, 1, 1, 0, 0, 0, 0, G, bx, true); EpiMerge<0> E{U, (bf16_t*)Y, AB}; pg8::gemm_phase(lds, pg8::Gemm{LDU, DM, DM}, S, E); }
            { pg8::Sched S; S.init(U + U_DAQ, WBR + (size_t)DM * DM, LDU, DM, 64, 4, 1, 1, 0, 0, 0, 0, G, bx, true); EpiMerge<1> E{U, (bf16_t*)Y, AB}; pg8::gemm_phase(lds, pg8::Gemm{LDU, DM, DM}, S, E); }
            { pg8::Sched S; S.init(U + U_FN, WBR + (size_t)2 * DM * DM, LDU, DM, 64, 4, 1, 1, 0, 0, 0, 0, G, bx, true); EpiMerge<2> E{U, (bf16_t*)Y, AB}; pg8::gemm_phase(lds, pg8::Gemm{LDU, DM, DM}, S, E); }
            if (need_ctx) {
                const bf16_t* Uc = U + (size_t)ML_ROWS * LDU;
                { pg8::Sched S; S.init(Uc + U_OG, WBR, LDU, DM, 4, 4, 1, 1, 0, 0, 0, 0, G, (bx + 48) % G, false); EpiMergeCtx E{U, YC, 0}; pg8::gemm_phase(lds, pg8::Gemm{LDU, DM, DM}, S, E); }
                { pg8::Sched S; S.init(Uc + U_DAQ, WBR + (size_t)DM * DM, LDU, DM, 4, 4, 1, 1, 0, 0, 0, 0, G, (bx + 32) % G, false); EpiMergeCtx E{U, YC + (size_t)MC_ROWS * DM, 1}; pg8::gemm_phase(lds, pg8::Gemm{LDU, DM, DM}, S, E); }
                { pg8::Sched S; S.init(Uc + U_FN, WBR + (size_t)2 * DM * DM, LDU, DM, 4, 4, 1, 1, 0, 0, 0, 0, G, (bx + 16) % G, false); EpiMergeCtx E{U, YC + (size_t)2 * MC_ROWS * DM, 2}; pg8::gemm_phase(lds, pg8::Gemm{LDU, DM, DM}, S, E); }
            }
            if (l + 1 < DEPTH) convert_dynamic(P, lds, l + 1, 0, 10, CTR + 4 * l);
        }
        xcd_barrier(xbar);
        if (need_ctx) {
            int t5 = threadIdx.x; asm volatile("" : "+v"(t5)); const int l5 = t5 & 63, gw5 = bx * 8 + (t5 >> 6);
            for (int row = gw5; row < MC_ROWS; row += NGW) {
#pragma unroll
                for (int j = 0; j < 4; ++j) { const size_t o = (size_t)row * DM + 4 * l5 + 256 * j;
                    const f32x4 y = *(const f32x4*)(YC + o) + *(const f32x4*)(YC + (size_t)MC_ROWS * DM + o) + *(const f32x4*)(YC + (size_t)2 * MC_ROWS * DM + o);
                    u32x2 w; w.x = cvt_pk_bf16(y[0], y[1]); w.y = cvt_pk_bf16(y[2], y[3]); *(u32x2*)(AB + (size_t)(ML_ROWS + row) * DM + 4 * l5 + 256 * j) = w; }
            }
            xcd_barrier(xbar);
        }
        {
            pg8::Sched S; S.init(AB, WOUT, DM, DM, 64, 4, 1, 1, 0, 0, 0, 0, G, bx, true);
            EpiResid E{srcL, srcC, P.out, XC, mods + 2 * 1024};
            pg8::gemm_phase(lds, pg8::Gemm{DM, DM, DM}, S, E);
            if (need_ctx) {
                pg8::Sched S2; S2.init(AB + (size_t)ML_ROWS * DM, WOUT, DM, DM, 4, 4, 2, 1, 1024, 0, 1024, 0, G, (bx + 112) % G, false);
                EpiResidCtxHalf E2{XC, TP6, mods + 4 * 6144 + 2 * 1024};
                pg8::gemm_phase(lds, pg8::Gemm{DM, DM, 512}, S2, E2);
            }
            if (l + 1 < DEPTH) convert_dynamic(P, lds, l + 1, 10, 13, CTR + 4 * l + 1);
        }
        xcd_barrier(xbar);
        {
            const int nrows = need_ctx ? MROWS : ML_ROWS;
            int tid7 = threadIdx.x; asm volatile("" : "+v"(tid7)); const int lane = tid7 & 63, gw = bx * 8 + (tid7 >> 6);
            for (int row = gw; row < nrows; row += NGW) { const bool lat = row < ML_ROWS; const int s = lat ? row >> 12 : 4;
                const float* xr = lat ? P.out + (size_t)row * DM : XC + (size_t)(row - ML_ROWS) * DM;
                if (lat) norm_mod_row(xr, P.norm_g + (size_t)(l * 2 + 1) * DM, mods + s * 6144 + 3 * 1024, mods + s * 6144 + 4 * 1024, AB + (size_t)row * DM, lane);
                else norm_mod_row(xr, P.norm_g + (size_t)(l * 2 + 1) * DM, mods + s * 6144 + 3 * 1024, mods + s * 6144 + 4 * 1024, AB + (size_t)row * DM, lane, TP6 + (size_t)(row - ML_ROWS) * DM, XC + (size_t)(row - ML_ROWS) * DM); }
        }
        xcd_barrier(xbar);
        {
            pg8::Sched S; S.init(AB, WF1, DM, DM, nMr, 22, 1, 1, 0, 0, 0, 0, G, bx, true);
            EpiSwiglu E{HID};
            pg8::gemm_phase(lds, pg8::Gemm{DM, DM, DM}, S, E);
        }
        xcd_barrier(xbar);
        {
            pg8::Sched S; S.init(HID, WF2, DFF, DFF, 64, 4, 1, 1, 0, 0, 0, 0, G, bx, true);
            EpiResid E{P.out, XC, P.out, XC, mods + 5 * 1024};
            pg8::gemm_phase(lds, pg8::Gemm{DFF, DFF, DFF}, S, E);
            if (need_ctx) {
                pg8::Sched S2; S2.init(HID + (size_t)ML_ROWS * DFF, WF2, DFF, DFF, 4, 4, 2, 1, 2816, 0, 2816, 0, G, (bx + 112) % G, false);
                EpiResidCtxHalf E2{XC, TP9, mods + 4 * 6144 + 5 * 1024};
                pg8::gemm_phase(lds, pg8::Gemm{DFF, DFF, 1408}, S2, E2);
            }
            if (l + 1 < DEPTH) convert_dynamic(P, lds, l + 1, 13, 15, CTR + 4 * l + 2);
        }
        xcd_barrier(xbar);
    }
    int tidf = threadIdx.x; asm volatile("" : "+v"(tidf));
    const int lane = tidf & 63, gw = bx * 8 + (tidf >> 6);
    for (int row = gw; row < ML_ROWS; row += 2 * NGW) {
        const int row2 = row + NGW; const bool ok2 = row2 < ML_ROWS;
        float* xa = P.out + (size_t)row * DM; float* xb = P.out + (size_t)(ok2 ? row2 : row) * DM; f32x4 va[4], vb[4]; float sa = 0.f, sb = 0.f;
#pragma unroll
        for (int j = 0; j < 4; ++j) { va[j] = *(const f32x4*)(xa + 4 * lane + 256 * j); vb[j] = *(const f32x4*)(xb + 4 * lane + 256 * j); }
#pragma unroll
        for (int j = 0; j < 4; ++j) { sa += (va[j][0] * va[j][0] + va[j][1] * va[j][1]) + (va[j][2] * va[j][2] + va[j][3] * va[j][3]); sb += (vb[j][0] * vb[j][0] + vb[j][1] * vb[j][1]) + (vb[j][2] * vb[j][2] + vb[j][3] * vb[j][3]); }
        const float ra = 1.0f / sqrtf(wave_sum(sa) * (1.0f / DM) + EPS), rb = 1.0f / sqrtf(wave_sum(sb) * (1.0f / DM) + EPS);
#pragma unroll
        for (int j = 0; j < 4; ++j) { const f32x4 fg = *(const f32x4*)(P.final_g + 4 * lane + 256 * j);
            *(f32x4*)(xa + 4 * lane + 256 * j) = va[j] * ra * fg; if (ok2) *(f32x4*)(xb + 4 * lane + 256 * j) = vb[j] * rb * fg; }
    }
}

extern "C" void kernel_launch(void* const* d_in, const int* in_sizes, int n_in, void* d_out, int out_size, void* d_ws, size_t ws_size, hipStream_t stream) {
    static int grid_blocks = 0;
    if (grid_blocks == 0) {
        if (n_in != 19 || ws_size < WS_END) { fprintf(stderr, "kernel_launch: need 19 inputs and %zu bytes of workspace (got %d, %zu)\n", (size_t)WS_END, n_in, ws_size); grid_blocks = -1; return; }
        int dev = 0, cus = 0, per_cu = 0;
        hipGetDevice(&dev);
        hipDeviceGetAttribute(&cus, hipDeviceAttributeMultiprocessorCount, dev);
        hipFuncSetAttribute((const void*)fwd_megakernel, hipFuncAttributeMaxDynamicSharedMemorySize, LDS_BYTES);
        hipOccupancyMaxActiveBlocksPerMultiprocessor(&per_cu, (const void*)fwd_megakernel, 512, LDS_BYTES);
        if (per_cu < 1) per_cu = 1;
        grid_blocks = cus * per_cu;
    }
    if (grid_blocks < 0) return;
    Params p{};
    const float** pp = (const float**)&p;
    for (int i = 0; i < 19; ++i) pp[i] = (const float*)d_in[i];
    p.out = (float*)d_out; p.ws = (unsigned char*)d_ws;
    (void)hipMemsetAsync((char*)d_ws + WS_CTR, 0, 256 + 3456 * 4, stream);
    void* args[] = {&p};
    hipError_t e = hipLaunchCooperativeKernel((const void*)fwd_megakernel, dim3(grid_blocks), dim3(512), args, LDS_BYTES, stream);
    if (e != hipSuccess) fprintf(stderr, "cooperative launch failed: %s (grid %d)\n", hipGetErrorString(e), grid_blocks);
}
```
